# Optimizing an MI355X kernel written in HIP

```python
import jax, jax.numpy as jnp
from jax import lax
import numpy as np

D_MODEL = 1024
BATCH = 8
SEQ = 4096
DEPTH = 2

MLA_HEADS = 8
QK_NOPE_DIM = 64
QK_ROPE_DIM = 32
V_HEAD_DIM = 64
Q_LORA_RANK = 256
KV_LORA_RANK = 128
QK_HEAD_DIM = QK_NOPE_DIM + QK_ROPE_DIM
D_ATTN = MLA_HEADS * V_HEAD_DIM
ROPE_THETA = 10000.0
Q_BLOCK = 128
SSD_HEADS = 8
SSD_HEAD_DIM = 64
SSD_GROUPS = 2
SSD_STATE = 128
CONV_WIDTH = 4
CHUNK = 128
D_SSD = SSD_HEADS * SSD_HEAD_DIM
D_CONV = D_SSD + 2 * SSD_GROUPS * SSD_STATE
D_MIX = D_ATTN + D_SSD
D_IN = Q_LORA_RANK + KV_LORA_RANK + QK_ROPE_DIM + D_SSD + D_CONV + SSD_HEADS
D_FF = ((-(-8 * D_MODEL // 3) + 255) // 256) * 256
N_MOD = 6
EPS = 1e-6

kernel_name = "hymba_mla_ssd_adaln_block"


def rmsnorm(x, w):
    xf = x.astype(jnp.float32)
    y = xf * lax.rsqrt(jnp.mean(xf * xf, axis=-1, keepdims=True) + EPS)
    return (y * w.astype(jnp.float32)).astype(x.dtype)


def rope(x, cos, sin):
    x1, x2 = jnp.split(x, 2, axis=-1)
    return jnp.concatenate([x1 * cos - x2 * sin, x2 * cos + x1 * sin], axis=-1)


def causal_attention(q, k, v):
    b, h, s, d = q.shape
    nb = s // Q_BLOCK
    scale = d ** -0.5
    qb = q.reshape(b, h, nb, Q_BLOCK, d).transpose(2, 0, 1, 3, 4)
    kpos = jnp.arange(s)

    def one_block(args):
        qi, i = args
        sc = jnp.einsum('bhqd,bhkd->bhqk', qi, k).astype(jnp.float32) * scale
        qpos = i * Q_BLOCK + jnp.arange(Q_BLOCK)
        mask = kpos[None, :] <= qpos[:, None]
        sc = jnp.where(mask, sc, jnp.finfo(jnp.float32).min)
        p = jax.nn.softmax(sc, axis=-1)
        return jnp.einsum('bhqk,bhkd->bhqd', p.astype(v.dtype), v)

    out = lax.map(one_block, (qb, jnp.arange(nb)))
    return out.transpose(1, 0, 3, 2, 4).reshape(b, s, h * v.shape[-1])


def ssd_chunked(x, dt, a, bm, cm):
    b, l, h, p = x.shape
    rep = h // bm.shape[2]
    nc = l // CHUNK
    xf = x.astype(jnp.float32)
    xdt = xf * dt[..., None]
    adt = dt * a
    bh = jnp.repeat(bm.astype(jnp.float32), rep, axis=2)
    ch = jnp.repeat(cm.astype(jnp.float32), rep, axis=2)
    n = bh.shape[-1]
    xc = xdt.reshape(b, nc, CHUNK, h, p)
    bc = bh.reshape(b, nc, CHUNK, h, n)
    cc = ch.reshape(b, nc, CHUNK, h, n)
    acs = jnp.cumsum(adt.reshape(b, nc, CHUNK, h), axis=2)
    seg = acs[:, :, :, None, :] - acs[:, :, None, :, :]
    tri = jnp.tril(jnp.ones((CHUNK, CHUNK), dtype=bool))[None, None, :, :, None]
    lmat = jnp.exp(jnp.where(tri, seg, -jnp.inf))
    scores = jnp.einsum('bclhn,bcshn->bclsh', cc, bc) * lmat
    y_diag = jnp.einsum('bclsh,bcshp->bclhp', scores, xc)
    decay_states = jnp.exp(acs[:, :, -1:, :] - acs)
    states = jnp.einsum('bcshn,bcsh,bcshp->bchpn', bc, decay_states, xc)
    chunk_decay = jnp.exp(acs[:, :, -1, :])

    def step(carry, inp):
        s_c, d_c = inp
        new = d_c[:, :, None, None] * carry + s_c
        return new, carry

    init = jnp.zeros((b, h, p, n), jnp.float32)
    _, prev = lax.scan(step, init, (states.transpose(1, 0, 2, 3, 4), chunk_decay.transpose(1, 0, 2)))
    prev = prev.transpose(1, 0, 2, 3, 4)
    y_off = jnp.einsum('bclhn,bchpn,bclh->bclhp', cc, prev, jnp.exp(acs))
    return (y_diag + y_off).reshape(b, l, h, p)


def hybrid_mixer(h, cos, sin, w_in, q_a_norm_w, w_q_up, kv_a_norm_w, w_kv_up,
                 q_nope_norm_w, q_pe_norm_w, k_nope_norm_w, k_pe_norm_w,
                 conv_w, conv_b, dt_bias, a_log, d_skip, ssd_norm_w, w_out):
    b, s, _ = h.shape
    proj = h @ w_in
    cuts = np.cumsum([Q_LORA_RANK, KV_LORA_RANK, QK_ROPE_DIM, D_SSD, D_CONV])
    q_a, kv_a, k_pe, z, xbc, dt_raw = jnp.split(proj, [int(i) for i in cuts], axis=-1)

    q = (rmsnorm(q_a, q_a_norm_w) @ w_q_up).reshape(b, s, MLA_HEADS, QK_HEAD_DIM)
    q_nope, q_pe = jnp.split(q, [QK_NOPE_DIM], axis=-1)
    kv = (rmsnorm(kv_a, kv_a_norm_w) @ w_kv_up).reshape(b, s, MLA_HEADS, QK_NOPE_DIM + V_HEAD_DIM)
    k_nope, v = jnp.split(kv, [QK_NOPE_DIM], axis=-1)
    q_nope = rmsnorm(q_nope, q_nope_norm_w)
    q_pe = rope(rmsnorm(q_pe, q_pe_norm_w), cos, sin)
    k_nope = rmsnorm(k_nope, k_nope_norm_w)
    k_pe = rope(rmsnorm(k_pe[:, :, None, :], k_pe_norm_w), cos, sin)
    q_full = jnp.concatenate([q_nope, q_pe], axis=-1)
    k_full = jnp.concatenate([k_nope, jnp.broadcast_to(k_pe, (b, s, MLA_HEADS, QK_ROPE_DIM))], axis=-1)
    attn_out = causal_attention(q_full.transpose(0, 2, 1, 3), k_full.transpose(0, 2, 1, 3),
                                v.transpose(0, 2, 1, 3))

    xbc = lax.conv_general_dilated(xbc, conv_w[:, None, :], window_strides=(1,),
                                   padding=[(CONV_WIDTH - 1, 0)],
                                   dimension_numbers=('NWC', 'WIO', 'NWC'),
                                   feature_group_count=D_CONV)
    xbc = jax.nn.silu(xbc + conv_b)
    xs, bm, cm = jnp.split(xbc, [D_SSD, D_SSD + SSD_GROUPS * SSD_STATE], axis=-1)
    xs = xs.reshape(b, s, SSD_HEADS, SSD_HEAD_DIM)
    bm = bm.reshape(b, s, SSD_GROUPS, SSD_STATE)
    cm = cm.reshape(b, s, SSD_GROUPS, SSD_STATE)
    dt = jax.nn.softplus(dt_raw.astype(jnp.float32) + dt_bias.astype(jnp.float32))
    a = -jnp.exp(a_log.astype(jnp.float32))
    y = ssd_chunked(xs, dt, a, bm, cm) + d_skip.astype(jnp.float32)[:, None] * xs.astype(jnp.float32)
    y = y.astype(h.dtype).reshape(b, s, D_SSD)
    yg = (y * jax.nn.silu(z)).reshape(b, s, SSD_GROUPS, D_SSD // SSD_GROUPS)
    yg = rmsnorm(yg, jnp.ones((D_SSD // SSD_GROUPS,), h.dtype)).reshape(b, s, D_SSD) * ssd_norm_w

    return jnp.concatenate([attn_out, yg], axis=-1) @ w_out


def swiglu(h, w_gate_up, w_down):
    g, u = jnp.split(h @ w_gate_up, 2, axis=-1)
    return (jax.nn.silu(g) * u) @ w_down


def setup_inputs(seed: int = 0) -> dict:
    key = jax.random.key(seed)
    ks = jax.random.split(key, 32)
    f32 = jnp.float32

    def nrm(k, shape, scale):
        return jax.random.normal(k, shape, f32) * scale

    def gain(k, shape):
        return 1.0 + 0.05 * jax.random.normal(k, shape, f32)

    L = DEPTH
    dt0 = jnp.exp(jax.random.uniform(ks[18], (L, SSD_HEADS), f32, np.log(1e-3), np.log(1e-1)))
    dt_bias = dt0 + jnp.log(-jnp.expm1(-dt0))
    pos_off = jax.random.randint(ks[2], (BATCH, 1), 0, 1024, dtype=jnp.int32)
    return {
        "x": nrm(ks[0], (BATCH, SEQ, D_MODEL), 1.0),
        "c": nrm(ks[1], (BATCH, D_MODEL), 1.0),
        "positions": pos_off + jnp.arange(SEQ, dtype=jnp.int32)[None, :],
        "norm1_w": gain(ks[3], (L, D_MODEL)),
        "norm2_w": gain(ks[4], (L, D_MODEL)),
        "w_ada": nrm(ks[5], (L, D_MODEL, N_MOD * D_MODEL), 0.5 * D_MODEL ** -0.5),
        "b_ada": nrm(ks[6], (L, N_MOD * D_MODEL), 0.01),
        "w_in": nrm(ks[7], (L, D_MODEL, D_IN), D_MODEL ** -0.5),
        "q_a_norm_w": gain(ks[8], (L, Q_LORA_RANK)),
        "w_q_up": nrm(ks[9], (L, Q_LORA_RANK, MLA_HEADS * QK_HEAD_DIM), Q_LORA_RANK ** -0.5),
        "kv_a_norm_w": gain(ks[10], (L, KV_LORA_RANK)),
        "w_kv_up": nrm(ks[11], (L, KV_LORA_RANK, MLA_HEADS * (QK_NOPE_DIM + V_HEAD_DIM)), KV_LORA_RANK ** -0.5),
        "q_nope_norm_w": gain(ks[12], (L, QK_NOPE_DIM)),
        "q_pe_norm_w": gain(ks[13], (L, QK_ROPE_DIM)),
        "k_nope_norm_w": gain(ks[14], (L, QK_NOPE_DIM)),
        "k_pe_norm_w": gain(ks[15], (L, QK_ROPE_DIM)),
        "conv_w": nrm(ks[16], (L, CONV_WIDTH, D_CONV), CONV_WIDTH ** -0.5),
        "conv_b": nrm(ks[17], (L, D_CONV), 0.01),
        "dt_bias": dt_bias,
        "a_log": jnp.log(jax.random.uniform(ks[19], (L, SSD_HEADS), f32, 1.0, 16.0)),
        "d_skip": 1.0 + 0.1 * jax.random.normal(ks[20], (L, SSD_HEADS), f32),
        "ssd_norm_w": gain(ks[21], (L, D_SSD)),
        "w_out": nrm(ks[22], (L, D_MIX, D_MODEL), D_MIX ** -0.5),
        "w_gate_up": nrm(ks[23], (L, D_MODEL, 2 * D_FF), D_MODEL ** -0.5),
        "w_down": nrm(ks[24], (L, D_FF, D_MODEL), D_FF ** -0.5),
    }


def reference(x, c, positions, norm1_w, norm2_w, w_ada, b_ada, w_in, q_a_norm_w, w_q_up,
              kv_a_norm_w, w_kv_up, q_nope_norm_w, q_pe_norm_w, k_nope_norm_w, k_pe_norm_w,
              conv_w, conv_b, dt_bias, a_log, d_skip, ssd_norm_w, w_out, w_gate_up, w_down):
    inv_freq = 1.0 / (ROPE_THETA ** (jnp.arange(0, QK_ROPE_DIM, 2, dtype=jnp.float32) / QK_ROPE_DIM))
    ang = positions.astype(jnp.float32)[..., None] * inv_freq
    cos = jnp.cos(ang)[:, :, None, :].astype(x.dtype)
    sin = jnp.sin(ang)[:, :, None, :].astype(x.dtype)
    c_act = jax.nn.silu(c)
    for l in range(DEPTH):
        mod = (c_act @ w_ada[l] + b_ada[l])[:, None, :]
        sh1, sc1, g1, sh2, sc2, g2 = jnp.split(mod, N_MOD, axis=-1)
        h = rmsnorm(x, norm1_w[l]) * (1.0 + sc1) + sh1
        x = x + g1 * hybrid_mixer(h, cos, sin, w_in[l], q_a_norm_w[l], w_q_up[l], kv_a_norm_w[l],
                                  w_kv_up[l], q_nope_norm_w[l], q_pe_norm_w[l], k_nope_norm_w[l],
                                  k_pe_norm_w[l], conv_w[l], conv_b[l], dt_bias[l], a_log[l],
                                  d_skip[l], ssd_norm_w[l], w_out[l])
        h = rmsnorm(x, norm2_w[l]) * (1.0 + sc2) + sh2
        x = x + g2 * swiglu(h, w_gate_up[l], w_down[l])
    return x
```

```cpp
#include <hip/hip_runtime.h>
#include <hip/hip_cooperative_groups.h>
#include <cstdio>
#include <cstdint>
namespace cg = cooperative_groups;
namespace pg8 {
#define PG8_LAS __attribute__((address_space(3)))
typedef unsigned short bf16_t;
typedef short bf16x8 __attribute__((ext_vector_type(8)));
typedef float f32x4 __attribute__((ext_vector_type(4)));
typedef unsigned u32x4 __attribute__((ext_vector_type(4)));
constexpr int BM = 256, BK = 64, HALF = 128, HTB = HALF * BK * 2  , STAGE_BYTES = 8 * HTB, NXCD = 8, WGM = 8;

__host__ __device__ __forceinline__ int lds_byte(int r, int c) { const int st = (r >> 4) * 2 + (c >> 5), rr = r & 15, cc = c & 31, ob = rr * 64 + cc * 2; return st * 1024 + (ob ^ (((ob >> 9) & 1) << 5)); }
__host__ __device__ __forceinline__ void stage_rc(int b, int& R, int& C) { const int st = b / 1024, sb = b % 1024, swz = sb ^ (((sb >> 9) & 1) << 5); R = (st >> 1) * 16 + swz / 64; C = (st & 1) * 32 + (swz % 64) / 2; }
__host__ __device__ __forceinline__ int perm32(int rho) { const int n = rho >> 4, i = rho & 15; return 8 * (i >> 2) + 4 * n + (i & 3); }

struct Unit { int pm, pn; };
struct Gemm { const bf16_t* A; const bf16_t* Bt; int M, N, K; };

struct StaticOrder {
    int nM, nN, nwg, G, c;
    __host__ __device__ void init(int M, int N, int G_, int c_) { nM = M / BM; nN = N / BM; nwg = nM * nN; G = G_; c = c_; }
    __host__ __device__ bool next(int i, Unit& u) const {
        const long L = (long)i * G + c; if (L >= nwg) return false;
        int wgid = (int)L; { const int q = nwg / NXCD, r = nwg % NXCD, xcd = wgid % NXCD, off = wgid / NXCD; wgid = (xcd < r ? xcd * (q + 1) : r * (q + 1) + (xcd - r) * q) + off; }
        const int nig = WGM * nN, gid = wgid / nig, fm = gid * WGM, gsz = (nM - fm) < WGM ? (nM - fm) : WGM;
        u.pm = fm + ((wgid % nig) % gsz); u.pn = (wgid % nig) / gsz; return true;
    }
    __device__ __forceinline__ void a_ready(const Unit&) const {}
    __device__ __forceinline__ void done(const Unit&) const {}
    __device__ __forceinline__ int kofs(const Unit&) const { return 0; }
    __device__ __forceinline__ int ntl(const Unit&, int nt) const { return nt; }
};

__device__ __forceinline__ unsigned cvt_pk_bf16(float lo, float hi) { unsigned r; asm volatile("v_cvt_pk_bf16_f32 %0, %1, %2" : "=v"(r) : "v"(lo), "v"(hi)); return r; }
typedef float f32x2 __attribute__((ext_vector_type(2)));
template <class Epi, class Sched, bool ALIGN_EPI = false, bool SP2 = false>
__device__ __forceinline__ void gemm_phase(PG8_LAS unsigned char* lds, const Gemm g, const Sched& S, const Epi& E) {
    int tid_ = threadIdx.x; asm volatile("" : "+v"(tid_));
    const int tid = tid_, wid = __builtin_amdgcn_readfirstlane(tid >> 6), lane = tid & 63, wr = wid >> 2, wc = wid & 3, fr = lane & 15, fq = lane >> 4;
    const int K = g.K, nt = K / BK;
    unsigned voffA[2], voffB[2];
#pragma unroll
    for (int i = 0; i < 2; ++i) { int R, C; stage_rc(tid * 16 + i * 8192, R, C); const int Rb = Epi::PERM ? ((R & ~31) + perm32(R & 31)) : R;
        voffA[i] = (unsigned)(R * K + C) * 2u; voffB[i] = (unsigned)(Rb * K + C) * 2u; }
    const size_t kstep = (size_t)(BK * 2);
    const size_t hstep = (size_t)HALF * K * 2;
    const size_t tstep = 2 * hstep;
    const unsigned ldsw = (unsigned)wid * 1024u;
    const int aoff = lds_byte(wr * 64 + fr, fq * 8), boff = lds_byte(wc * 32 + fr, fq * 8);
#define PG8_SA(b, h) (((b) * 2 + (h)) * HTB)
#define PG8_SB(b, h) ((4 + (b) * 2 + (h)) * HTB)
#define PG8_STAGE(bufoff, gbase, voff) do { _Pragma("unroll") for (int _i = 0; _i < 2; ++_i) \
        __builtin_amdgcn_global_load_lds((const unsigned*)((const char*)(gbase) + (voff)[_i]), (PG8_LAS unsigned*)(lds + (bufoff) + ldsw + _i * 8192), 16, 0, 0); } while (0)
#define PG8_LDA(dst, b, h) do { _Pragma("unroll") for (int m = 0; m < 4; ++m) _Pragma("unroll") for (int k = 0; k < 2; ++k) dst[m][k] = *(const PG8_LAS bf16x8*)(lds + PG8_SA(b, h) + aoff + m * 2048 + k * 1024); } while (0)
#define PG8_LDB(dst, b, h) do { _Pragma("unroll") for (int n = 0; n < 2; ++n) _Pragma("unroll") for (int k = 0; k < 2; ++k) dst[n][k] = *(const PG8_LAS bf16x8*)(lds + PG8_SB(b, h) + boff + n * 2048 + k * 1024); } while (0)
#define PG8_MMA(ai, bj, At, Bt) do { __builtin_amdgcn_s_setprio(1); _Pragma("unroll") for (int m = 0; m < 4; ++m) _Pragma("unroll") for (int n = 0; n < 2; ++n) _Pragma("unroll") for (int k = 0; k < 2; ++k) \
        acc[ai][bj][m][n] = __builtin_amdgcn_mfma_f32_16x16x32_bf16(Bt[n][k], At[m][k], acc[ai][bj][m][n], 0, 0, 0); __builtin_amdgcn_s_setprio(0); } while (0)
#define PG8_WAIT_V(n) asm volatile("s_waitcnt vmcnt(" #n ")" ::: "memory")
#define PG8_WAIT_L(n) asm volatile("s_waitcnt lgkmcnt(" #n ")" ::: "memory")
#define PG8_BAR __builtin_amdgcn_s_barrier()
#define PG8_SCHED __builtin_amdgcn_sched_barrier(0)
    Unit cur, nxt; int ui = 0;
    if (!S.next(0, cur)) return;
    f32x4 acc[2][2][4][2];
#pragma unroll
    for (int a = 0; a < 2; ++a)
#pragma unroll
        for (int b = 0; b < 2; ++b)
#pragma unroll
            for (int m = 0; m < 4; ++m)
#pragma unroll
                for (int n = 0; n < 2; ++n) acc[a][b][m][n] = (f32x4){0.f, 0.f, 0.f, 0.f};
    bf16x8 At[4][2], B0[2][2], B1[2][2];
    const char* cA = (const char*)g.A + (size_t)cur.pm * tstep + S.kofs(cur); const char* cB = (const char*)g.Bt + (size_t)cur.pn * tstep + S.kofs(cur);
    S.a_ready(cur);
    if constexpr (SP2) {
        PG8_STAGE(PG8_SB(0, 0), cB, voffB); PG8_STAGE(PG8_SB(0, 1), cB + hstep, voffB); PG8_STAGE(PG8_SA(0, 0), cA, voffA); PG8_STAGE(PG8_SA(0, 1), cA + hstep, voffA);
        if (wr == 1) PG8_BAR;
        PG8_WAIT_V(2); PG8_BAR;
        PG8_STAGE(PG8_SB(1, 0), cB + kstep, voffB); PG8_STAGE(PG8_SA(1, 0), cA + kstep, voffA); PG8_STAGE(PG8_SB(1, 1), cB + hstep + kstep, voffB);
        PG8_WAIT_V(6); PG8_BAR;
    } else {
        PG8_STAGE(PG8_SB(0, 0), cB, voffB); PG8_STAGE(PG8_SA(0, 0), cA, voffA); PG8_STAGE(PG8_SB(0, 1), cB + hstep, voffB); PG8_STAGE(PG8_SA(0, 1), cA + hstep, voffA);
        if (wr == 1) PG8_BAR;
        PG8_WAIT_V(4); PG8_BAR;
        PG8_STAGE(PG8_SB(1, 0), cB + kstep, voffB); PG8_STAGE(PG8_SA(1, 0), cA + kstep, voffA); PG8_STAGE(PG8_SB(1, 1), cB + hstep + kstep, voffB);
        PG8_WAIT_V(6); PG8_BAR;
    }
    for (;;) {
        const bool has_next = S.next(ui + 1, nxt);
        const char* nA = has_next ? (const char*)g.A + (size_t)nxt.pm * tstep + S.kofs(nxt) : cA; const char* nB = has_next ? (const char*)g.Bt + (size_t)nxt.pn * tstep + S.kofs(nxt) : cB;
        const int ntu = S.ntl(cur, nt);
        for (int t = 0; t < ntu; t += 2) {
            const bool last = (t == ntu - 2);
            const char* a1 = cA + (size_t)(t + 1) * kstep;
            const char* a2 = last ? nA : cA + (size_t)(t + 2) * kstep; const char* b2 = last ? nB : cB + (size_t)(t + 2) * kstep;
            const char* a3 = a2 + kstep; const char* b3 = b2 + kstep;
            if (last && has_next) S.a_ready(nxt);
            if constexpr (SP2) {
            PG8_LDB(B0, 0, 0); PG8_LDB(B1, 0, 1); PG8_SCHED; PG8_LDA(At, 0, 0); PG8_STAGE(PG8_SA(1, 1), a1 + hstep, voffA);
            PG8_WAIT_V(8); PG8_WAIT_L(0); PG8_BAR; PG8_MMA(0, 0, At, B0); PG8_MMA(0, 1, At, B1); PG8_BAR; PG8_SCHED;
            PG8_LDA(At, 0, 1); PG8_STAGE(PG8_SB(0, 0), b2, voffB); PG8_STAGE(PG8_SB(0, 1), b2 + hstep, voffB); PG8_STAGE(PG8_SA(0, 0), a2, voffA);
            PG8_WAIT_V(8); PG8_WAIT_L(0); PG8_BAR; PG8_MMA(1, 0, At, B0); PG8_MMA(1, 1, At, B1); PG8_BAR; PG8_SCHED;
            PG8_LDB(B0, 1, 0); PG8_LDB(B1, 1, 1); PG8_SCHED; PG8_LDA(At, 1, 0); PG8_STAGE(PG8_SA(0, 1), a2 + hstep, voffA);
            PG8_WAIT_V(8); PG8_WAIT_L(0); PG8_BAR; PG8_MMA(0, 0, At, B0); PG8_MMA(0, 1, At, B1); PG8_BAR; PG8_SCHED;
            PG8_LDA(At, 1, 1); PG8_STAGE(PG8_SB(1, 0), b3, voffB); PG8_STAGE(PG8_SB(1, 1), b3 + hstep, voffB); PG8_STAGE(PG8_SA(1, 0), a3, voffA);
            PG8_WAIT_V(8); PG8_WAIT_L(0); PG8_BAR; PG8_MMA(1, 0, At, B0); PG8_MMA(1, 1, At, B1); PG8_BAR; PG8_SCHED;
            } else {
            PG8_LDB(B0, 0, 0); PG8_SCHED; PG8_LDA(At, 0, 0); PG8_STAGE(PG8_SA(1, 1), a1 + hstep, voffA);
            PG8_WAIT_L(8); PG8_BAR; PG8_WAIT_L(0); PG8_MMA(0, 0, At, B0); PG8_BAR; PG8_SCHED;
            PG8_LDB(B1, 0, 1); PG8_STAGE(PG8_SB(0, 0), b2, voffB);
            PG8_BAR; PG8_WAIT_L(0); PG8_MMA(0, 1, At, B1); PG8_BAR;
            PG8_LDA(At, 0, 1); PG8_STAGE(PG8_SA(0, 0), a2, voffA);
            PG8_BAR; PG8_WAIT_L(0); PG8_MMA(1, 0, At, B0); PG8_BAR; PG8_SCHED;
            PG8_STAGE(PG8_SB(0, 1), b2 + hstep, voffB);
            PG8_WAIT_V(6); PG8_BAR; PG8_MMA(1, 1, At, B1); PG8_BAR;
            PG8_LDB(B0, 1, 0); PG8_SCHED; PG8_LDA(At, 1, 0); PG8_STAGE(PG8_SA(0, 1), a2 + hstep, voffA);
            PG8_WAIT_L(8); PG8_BAR; PG8_WAIT_L(0); PG8_MMA(0, 0, At, B0); PG8_BAR; PG8_SCHED;
            PG8_LDB(B1, 1, 1); PG8_STAGE(PG8_SB(1, 0), b3, voffB);
            PG8_BAR; PG8_WAIT_L(0); PG8_MMA(0, 1, At, B1); PG8_BAR;
            PG8_LDA(At, 1, 1); PG8_STAGE(PG8_SA(1, 0), a3, voffA);
            PG8_BAR; PG8_WAIT_L(0); PG8_MMA(1, 0, At, B0); PG8_BAR; PG8_SCHED;
            PG8_STAGE(PG8_SB(1, 1), b3 + hstep, voffB);
            PG8_WAIT_V(6); PG8_BAR; PG8_MMA(1, 1, At, B1); PG8_BAR;
            }
        }
        if constexpr (ALIGN_EPI) { if (wr == 0) PG8_BAR; }
        if constexpr (!Epi::AFTER_DRAIN) { E(acc, cur, wr, wc, fr, fq); S.done(cur); }
        if (!has_next) break;
#pragma unroll
        for (int a = 0; a < 2; ++a)
#pragma unroll
            for (int b = 0; b < 2; ++b)
#pragma unroll
                for (int m = 0; m < 4; ++m)
#pragma unroll
                    for (int n = 0; n < 2; ++n) acc[a][b][m][n] = (f32x4){0.f, 0.f, 0.f, 0.f};
        cur = nxt; cA = nA; cB = nB; ++ui;
        if constexpr (ALIGN_EPI) { if (wr == 1) PG8_BAR; }
    }
    PG8_WAIT_V(0);
    if constexpr (!ALIGN_EPI) { if (wr == 0) PG8_BAR; }
    PG8_BAR;
    if constexpr (Epi::AFTER_DRAIN) { E.fused(acc, cur, wr, wc, fr, fq, lds, wid, lane); S.done(cur); }
#undef PG8_SA
#undef PG8_SB
#undef PG8_STAGE
#undef PG8_LDA
#undef PG8_LDB
#undef PG8_MMA
#undef PG8_WAIT_V
#undef PG8_WAIT_L
#undef PG8_BAR
#undef PG8_SCHED
}
}

constexpr int NWAVES = 8;
constexpr int NB = 8, SEQ = 4096, T = NB * SEQ, D = 1024, DEPTH = 2;
constexpr int DINP = 2048;
constexpr int NQ = 768, NKV = 1024, DFF = 2816, NGU = 2 * DFF;
constexpr float EPS = 1e-6f;
constexpr int LDS_BYTES = 147456;
#ifndef LOOPN
#define LOOPN DEPTH
#endif

#define LAS __attribute__((address_space(3)))
typedef unsigned short bf16;
typedef float f32x4 __attribute__((ext_vector_type(4)));
typedef unsigned u32x4 __attribute__((ext_vector_type(4)));
typedef unsigned u32x2 __attribute__((ext_vector_type(2)));

constexpr size_t MiB = 1u << 20;
constexpr size_t WS_MOD = 0;
constexpr size_t WS_CTL = 480 * 1024;
constexpr size_t WS_PAR = 512 * 1024;
constexpr int P_N1W = 0, P_N2W = 1024, P_CONVW = 2048, P_CONVB = 6144, P_SSDNW = 7168, P_QNW = 7680, P_KNW = 7744, P_QPW = 7808, P_KPW = 7840, P_DTB = 7872, P_ALOG = 7880, P_DSKIP = 7888, P_STRIDE = 8192;
constexpr size_t WS_W = 1 * MiB;
constexpr size_t WO_IN = 0, WO_Q = WO_IN + (size_t)DINP * D * 2  , WO_OUT = WO_Q + (size_t)(NQ + NKV) * 512 * 2,
                 WO_GU = WO_OUT + (size_t)D * D * 2, WO_D = WO_GU + (size_t)NGU * D * 2, WL_STRIDE = WO_D + (size_t)D * DFF * 2;
static_assert(WS_W + 2 * WL_STRIDE <= 50 * MiB, "weights");
constexpr size_t WS_X1 = 50 * MiB;
constexpr size_t WS_QH = WS_X1, WS_KH = WS_QH + 48 * MiB, WS_VH = WS_KH + 48 * MiB;
constexpr size_t WS_H = 178 * MiB;
constexpr size_t WS_XBCC = WS_H;
constexpr size_t WS_R = 242 * MiB;
constexpr size_t WS_ACT = WS_R;
constexpr size_t WS_QA = WS_R  , WS_MISC = WS_QA + 32 * MiB, WS_Z = WS_MISC + 8 * MiB, WS_XBC = WS_Z + 32 * MiB,
                 WS_Y = WS_XBC, WS_QU = WS_XBC + 64 * MiB  , WS_MIX = WS_QU,
                 WS_SM = WS_QU + 112 * MiB;
constexpr size_t WS_RINV = WS_SM, WS_KPE = WS_RINV + (size_t)T * 8, WS_DT = WS_KPE + (size_t)T * 64, WS_COS = WS_DT + (size_t)T * 32, WS_SIN = WS_COS + (size_t)T * 64,
                 WS_CDEC = WS_SIN + (size_t)T * 64, WS_END = WS_CDEC + 2048 * 4;
constexpr size_t WS_ST = WS_QU + 64 * MiB;
static_assert(WS_END <= 512 * MiB, "d_ws map");

__device__ __forceinline__ float bf2f(unsigned u) { return __uint_as_float(u << 16); }
__device__ __forceinline__ unsigned f2bf(float f) { unsigned u = __float_as_uint(f); return (u + 0x7fffu + ((u >> 16) & 1u)) >> 16; }
typedef __bf16 hwbf16x2 __attribute__((ext_vector_type(2)));
typedef float f32x2 __attribute__((ext_vector_type(2)));
__device__ __forceinline__ unsigned pk2(float lo, float hi) { const f32x2 v = {lo, hi}; return __builtin_bit_cast(unsigned, __builtin_convertvector(v, hwbf16x2)); }
__device__ __forceinline__ float lo16(unsigned w) { return __uint_as_float(w << 16); }
__device__ __forceinline__ float hi16(unsigned w) { return __uint_as_float(w & 0xffff0000u); }
__device__ __forceinline__ float silu_f(float v) { return v * __builtin_amdgcn_rcpf(1.f + __expf(-v)); }
__device__ __forceinline__ float wave_sum(float v) {
#pragma unroll
    for (int o = 1; o < 64; o <<= 1) v += __shfl_xor(v, o);
    return v;
}
#define LDS_WAIT() asm volatile("s_waitcnt lgkmcnt(0)" ::: "memory")
#define GAS __attribute__((address_space(1)))
#define TP_WRITE(d32, RW, va, vb) do { \
    (d32)[0 * (RW)] = ((va).x & 0xffffu) | ((vb).x << 16); (d32)[1 * (RW)] = ((va).x >> 16) | ((vb).x & 0xffff0000u); \
    (d32)[2 * (RW)] = ((va).y & 0xffffu) | ((vb).y << 16); (d32)[3 * (RW)] = ((va).y >> 16) | ((vb).y & 0xffff0000u); \
    (d32)[4 * (RW)] = ((va).z & 0xffffu) | ((vb).z << 16); (d32)[5 * (RW)] = ((va).z >> 16) | ((vb).z & 0xffff0000u); \
    (d32)[6 * (RW)] = ((va).w & 0xffffu) | ((vb).w << 16); (d32)[7 * (RW)] = ((va).w >> 16) | ((vb).w & 0xffff0000u); } while (0)
template <class T> __device__ __forceinline__ GAS T* as_global(T* p) { return (GAS T*)p; }

struct Args { const float* in[25]; float* out; unsigned char* ws; int ph_lo, ph_hi; };
static_assert(sizeof(Args) == 25 * 8 + 8 + 8 + 8, "Args has no padding");

enum { I_X = 0, I_C, I_POS, I_N1W, I_N2W, I_WADA, I_BADA, I_WIN, I_QANW, I_WQUP, I_KVANW, I_WKVUP, I_QNW, I_QPW, I_KNW, I_KPW, I_CONVW, I_CONVB, I_DTB, I_ALOG, I_DSKIP,
       I_SSDNW, I_WOUT, I_WGU, I_WDOWN };

__device__ __forceinline__ int src_col(int mat, int n) {
    switch (mat) {
    case 0:
        if (n < 416) return n;
        if (n < 424) return 1952 + (n - 416);
        if (n < 512) return -1;
        if (n < 1024) return 416 + (n - 512);
        return 928 + (n - 1024);
    case 1: {
        if (n < 512) { const int pn = n >> 8, bj = (n >> 7) & 1, wc = (n >> 5) & 3, j = n & 31; return (4 * pn + wc) * 96 + 32 * bj + j; }
        const int r = n - 512, bj = r >> 7, wc = (r >> 5) & 3, jc = r & 31;
        return (4 * bj + wc) * 96 + 64 + 16 * ((jc >> 2) & 1) + 4 * (jc >> 3) + (jc & 3); }
    case 2: {
        if (n < 512) { const int pn = n >> 8, bj = (n >> 7) & 1, wc = (n >> 5) & 3, j = n & 31; return (4 * pn + wc) * 128 + 32 * bj + j; }
        const int r = n - 512; return (r >> 6) * 128 + 64 + (r & 63); }
    case 3: return n;
    case 4: { const int pn = n >> 8, bj = (n >> 7) & 1, j = n & 127; return (bj ? DFF : 0) + 128 * pn + j; }
    default: return n;
    }
}
__device__ __forceinline__ void transpose_item(const GAS float* __restrict__ W, int Ksrc, int Nsrc, GAS bf16* WT, int Kdst, const GAS float* kscale, int mat, LAS float* scr, int kb, int nb, int lane, int koff = 0, int noff = 0) {
    const int k0 = 64 * kb, n0 = 32 * nb;
    const int ns = src_col(mat, n0 - noff + (lane & 31));
#pragma unroll
    for (int i = 0; i < 32; ++i) {
        const int kk = 2 * i + (lane >> 5), k = k0 + kk - koff;
        float v = 0.f;
        if (ns >= 0 && k >= 0 && k < Ksrc) { v = W[(size_t)k * Nsrc + ns]; if (kscale) v *= kscale[k]; }
        scr[kk * 33 + (lane & 31)] = v;
    }
    LDS_WAIT();
    const int c = lane & 7;
#pragma unroll
    for (int j = 0; j < 4; ++j) {
        const int n = (lane >> 3) + 8 * j; const LAS float* s = scr + (8 * c) * 33 + n;
        u32x4 o; o.x = pk2(s[0 * 33], s[1 * 33]); o.y = pk2(s[2 * 33], s[3 * 33]); o.z = pk2(s[4 * 33], s[5 * 33]); o.w = pk2(s[6 * 33], s[7 * 33]);
        *(GAS u32x4*)(WT + (size_t)(n0 + n) * Kdst + k0 + 8 * c) = o;
    }
    LDS_WAIT();
}

__device__ __forceinline__ void phase_prep(const Args& a, LAS unsigned char* lds, int tid, int lane, int wave) {
    GAS unsigned char* ws = as_global(a.ws);
    const int gw = blockIdx.x * NWAVES + wave, NGW = gridDim.x * NWAVES;
    LAS float* scr = (LAS float*)(lds + wave * 16384);
    constexpr int IT0 = 16 * 64, IT1 = 8 * 24, IT2 = 8 * 32, IT3 = 16 * 32, IT4 = 16 * 176, IT5 = 44 * 32, ITL = IT0 + IT1 + IT2 + IT3 + IT4 + IT5;
    for (int it = gw; it < 2 * ITL; it += NGW) {
        const int l = it / ITL; int r = it % ITL;
        GAS bf16* wl = (GAS bf16*)(ws + WS_W + (size_t)l * WL_STRIDE);
        if (r < IT0) { transpose_item(as_global(a.in[I_WIN]) + (size_t)l * D * 1960, D, 1960, (GAS bf16*)((GAS unsigned char*)wl + WO_IN), D, nullptr, 0, scr, r / 64, r % 64, lane); continue; } r -= IT0;
        if (r < IT1) { transpose_item(as_global(a.in[I_WQUP]) + (size_t)l * 256 * NQ, 256, NQ, (GAS bf16*)((GAS unsigned char*)wl + WO_Q), 512, as_global(a.in[I_QANW]) + l * 256, 1, scr, r / 24, r % 24, lane, 0, 0); continue; } r -= IT1;
        if (r < IT2) { transpose_item(as_global(a.in[I_WKVUP]) + (size_t)l * 128 * NKV, 128, NKV, (GAS bf16*)((GAS unsigned char*)wl + WO_Q), 512, as_global(a.in[I_KVANW]) + l * 128, 2, scr, r / 32, 24 + r % 32, lane, 256, 768); continue; } r -= IT2;
        if (r < IT3) { transpose_item(as_global(a.in[I_WOUT]) + (size_t)l * D * D, D, D, (GAS bf16*)((GAS unsigned char*)wl + WO_OUT), D, nullptr, 3, scr, r / 32, r % 32, lane); continue; } r -= IT3;
        if (r < IT4) { transpose_item(as_global(a.in[I_WGU]) + (size_t)l * D * NGU, D, NGU, (GAS bf16*)((GAS unsigned char*)wl + WO_GU), D, nullptr, 4, scr, r / 176, r % 176, lane); continue; } r -= IT4;
        transpose_item(as_global(a.in[I_WDOWN]) + (size_t)l * DFF * D, DFF, D, (GAS bf16*)((GAS unsigned char*)wl + WO_D), DFF, nullptr, 5, scr, r / 32, r % 32, lane);
    }
    {
        GAS float* PAR = (GAS float*)(ws + WS_PAR);
        for (int i = blockIdx.x * 512 + tid; i < 2 * P_STRIDE; i += gridDim.x * 512) {
            const int l = i / P_STRIDE, r = i % P_STRIDE; float v = 0.f;
            if (r < P_N2W) v = as_global(a.in[I_N1W])[l * 1024 + r];
            else if (r < P_CONVW) v = as_global(a.in[I_N2W])[l * 1024 + r - P_N2W];
            else if (r < P_CONVB) v = as_global(a.in[I_CONVW])[l * 4096 + r - P_CONVW];
            else if (r < P_SSDNW) v = as_global(a.in[I_CONVB])[l * 1024 + r - P_CONVB];
            else if (r < P_QNW) v = as_global(a.in[I_SSDNW])[l * 512 + r - P_SSDNW];
            else if (r < P_KNW) v = as_global(a.in[I_QNW])[l * 64 + r - P_QNW];
            else if (r < P_QPW) v = as_global(a.in[I_KNW])[l * 64 + r - P_KNW];
            else if (r < P_KPW) v = as_global(a.in[I_QPW])[l * 32 + r - P_QPW];
            else if (r < P_DTB) v = as_global(a.in[I_KPW])[l * 32 + r - P_KPW];
            else if (r < P_ALOG) v = as_global(a.in[I_DTB])[l * 8 + r - P_DTB];
            else if (r < P_DSKIP) v = as_global(a.in[I_ALOG])[l * 8 + r - P_ALOG];
            else if (r < P_DSKIP + 8) v = as_global(a.in[I_DSKIP])[l * 8 + r - P_DSKIP];
            PAR[i] = v;
        }
    }
    {
        GAS float* COS = (GAS float*)(ws + WS_COS); GAS float* SIN = (GAS float*)(ws + WS_SIN); const GAS int* pos = (const GAS int*)as_global(a.in[I_POS]);
        for (int i = blockIdx.x * 512 + tid; i < T * 16; i += gridDim.x * 512) {
            const int t = i >> 4, j = i & 15;
            const float invf = 1.0f / powf(10000.0f, (float)(2 * j) / 32.0f);
            const float ang = (float)pos[t] * invf;
            const double rev = (double)ang * 0.15915494309189533577;
            const float fr = (float)(rev - rint(rev));
            SIN[i] = __builtin_amdgcn_sinf(fr); COS[i] = __builtin_amdgcn_cosf(fr);
        }
    }
}
__device__ __forceinline__ void phase_prep_mod(const Args& a, LAS unsigned char* lds, int tid, int lane, int wave) {
    GAS unsigned char* ws = as_global(a.ws);
    {
        GAS float* MOD = (GAS float*)(ws + WS_MOD);
        LAS float* red = (LAS float*)lds;
        LAS float* cact = (LAS float*)(lds + 16384);
        for (int i = tid; i < 8 * D; i += 512) cact[i] = silu_f(as_global(a.in[I_C])[i]);
        __syncthreads();
        for (int it = blockIdx.x; it < 2 * 96; it += gridDim.x) {
            const int l = it / 96, cg = it % 96;
            const GAS float* wa = as_global(a.in[I_WADA]) + (size_t)l * D * 6144 + 64 * cg + lane;
            float acc[8];
#pragma unroll
            for (int b = 0; b < 8; ++b) acc[b] = 0.f;
#pragma nounroll
            for (int kk0 = 0; kk0 < 128; kk0 += 16) {
                float w[16];
#pragma unroll
                for (int j = 0; j < 16; ++j) w[j] = wa[(size_t)(wave * 128 + kk0 + j) * 6144];
#pragma unroll
                for (int j4 = 0; j4 < 4; ++j4) {
#pragma unroll
                    for (int b = 0; b < 8; ++b) {
                        const f32x4 cv = *(const LAS f32x4*)(cact + b * D + wave * 128 + kk0 + 4 * j4);
                        acc[b] += cv[0] * w[4 * j4] + cv[1] * w[4 * j4 + 1] + cv[2] * w[4 * j4 + 2] + cv[3] * w[4 * j4 + 3];
                    }
                }
            }
#pragma unroll
            for (int b = 0; b < 8; ++b) red[(wave * 8 + b) * 64 + lane] = acc[b];
            __syncthreads();
            {
                float s = as_global(a.in[I_BADA])[l * 6144 + 64 * cg + lane];
#pragma unroll
                for (int w2 = 0; w2 < 8; ++w2) s += red[(w2 * 8 + wave) * 64 + lane];
                MOD[(size_t)(l * 8 + wave) * 6144 + 64 * cg + lane] = s;
            }
            __syncthreads();
        }
    }
}

template <bool IN_BF16>
__device__ __forceinline__ void phase_norm(const GAS void* __restrict__ x, const GAS float* __restrict__ nw, const GAS float* __restrict__ modl  , int sh_off, int sc_off, GAS bf16* H, int lane, int wave) {
    const int gw = blockIdx.x * NWAVES + wave, NGW = gridDim.x * NWAVES;
    for (int m = gw; m < T; m += NGW) {
        f32x4 v[4]; float s = 0.f;
#pragma unroll
        for (int j = 0; j < 4; ++j) {
            if (IN_BF16) { const u32x2 p = *((const GAS u32x2*)((const GAS bf16*)x + (size_t)m * D) + lane + 64 * j); v[j] = (f32x4){lo16(p.x), hi16(p.x), lo16(p.y), hi16(p.y)}; }
            else v[j] = *((const GAS f32x4*)((const GAS float*)x + (size_t)m * D) + lane + 64 * j);
            s += (v[j].x * v[j].x + v[j].y * v[j].y) + (v[j].z * v[j].z + v[j].w * v[j].w);
        }
        const float rinv = rsqrtf(wave_sum(s) * (1.f / D) + EPS);
        const GAS float* mb = modl + (size_t)(m >> 12) * 6144;
        GAS u32x2* o = (GAS u32x2*)(H + (size_t)m * D) + lane;
#pragma unroll
        for (int j = 0; j < 4; ++j) {
            const int c = 4 * lane + 256 * j;
            const f32x4 w = *(const GAS f32x4*)(nw + c), sc = *(const GAS f32x4*)(mb + sc_off + c), sh = *(const GAS f32x4*)(mb + sh_off + c);
            const f32x4 h = v[j] * rinv * w * (sc + 1.0f) + sh;
            u32x2 p; p.x = pk2(h.x, h.y); p.y = pk2(h.z, h.w); o[64 * j] = p;
        }
    }
}

using pg8::Unit; using pg8::cvt_pk_bf16;
#define EPI_PACK8(W_, v0, v1) do { (W_).x = cvt_pk_bf16(v0[0], v0[1]); (W_).y = cvt_pk_bf16(v0[2], v0[3]); (W_).z = cvt_pk_bf16(v1[0], v1[1]); (W_).w = cvt_pk_bf16(v1[2], v1[3]); } while (0)
struct EpiIn {
    static constexpr bool PERM = true, AFTER_DRAIN = false;
    GAS bf16*QA, *Z, *XBC; GAS float* MISC;
    __device__ __forceinline__ void operator()(const f32x4 (&acc)[2][2][4][2], const Unit& u, int wr, int wc, int fr, int fq) const {
        asm volatile("" : "+v"(fr), "+v"(fq));
        const int row0 = u.pm * 256 + wr * 64 + fr, cb = wc * 32 + 8 * fq, pn = u.pn;
        GAS bf16* base; int ldc;
        if (pn < 2) { base = QA + pn * 256; ldc = 512; } else if (pn < 4) { base = Z + (pn - 2) * 256; ldc = 512; } else { base = XBC + (pn - 4) * 256; ldc = 1024; }
#pragma unroll
        for (int ai = 0; ai < 2; ++ai)
#pragma unroll
            for (int m = 0; m < 4; ++m) {
                const int row = row0 + ai * 128 + m * 16;
#pragma unroll
                for (int bj = 0; bj < 2; ++bj) {
                    const f32x4 v0 = acc[ai][bj][m][0], v1 = acc[ai][bj][m][1];
                    u32x4 w; EPI_PACK8(w, v0, v1);
                    *(GAS u32x4*)(base + (size_t)row * ldc + bj * 128 + cb) = w;
                    if (pn == 1 && bj == 1 && wc < 2) { GAS float* mp = MISC + (size_t)row * 64 + cb; *(GAS f32x4*)mp = v0; *(GAS f32x4*)(mp + 4) = v1; }
                }
            }
    }
};
template <bool IN_BF16, bool OUT_BF16> struct EpiResT {
    static constexpr bool PERM = false, AFTER_DRAIN = false;
    const GAS void* xin; GAS void* out; const GAS float* gate;
    __device__ __forceinline__ void operator()(const f32x4 (&acc)[2][2][4][2], const Unit& u, int wr, int wc, int fr, int fq) const {
        asm volatile("" : "+v"(fr), "+v"(fq));
        const int row0 = u.pm * 256 + wr * 64 + fr, c0 = u.pn * 256 + wc * 32 + 4 * fq;
        const GAS float* gb = gate + (size_t)((u.pm * 256) >> 12) * 6144;
        f32x4 g[2][2];
#pragma unroll
        for (int bj = 0; bj < 2; ++bj)
#pragma unroll
            for (int n = 0; n < 2; ++n) g[bj][n] = *(const GAS f32x4*)(gb + c0 + bj * 128 + n * 16);
#pragma unroll
        for (int ai = 0; ai < 2; ++ai)
#pragma unroll
            for (int m = 0; m < 4; ++m) {
                const size_t off = (size_t)(row0 + ai * 128 + m * 16) * D + c0;
#pragma unroll
                for (int bj = 0; bj < 2; ++bj)
#pragma unroll
                    for (int n = 0; n < 2; ++n) {
                        const size_t o2 = off + bj * 128 + n * 16;
                        f32x4 xi;
                        if (IN_BF16) { const u32x2 p = *(const GAS u32x2*)((const GAS bf16*)xin + o2); xi = (f32x4){lo16(p.x), hi16(p.x), lo16(p.y), hi16(p.y)}; }
                        else xi = *(const GAS f32x4*)((const GAS float*)xin + o2);
                        const f32x4 o = xi + g[bj][n] * acc[ai][bj][m][n];
                        if (OUT_BF16) { u32x2 p; p.x = cvt_pk_bf16(o[0], o[1]); p.y = cvt_pk_bf16(o[2], o[3]); *(GAS u32x2*)((GAS bf16*)out + o2) = p; }
                        else *(GAS f32x4*)((GAS float*)out + o2) = o;
                    }
            }
    }
};
struct EpiSwiglu {
    static constexpr bool PERM = true, AFTER_DRAIN = false;
    GAS bf16* O;
    __device__ __forceinline__ void operator()(const f32x4 (&acc)[2][2][4][2], const Unit& u, int wr, int wc, int fr, int fq) const {
        asm volatile("" : "+v"(fr), "+v"(fq));
        const int row0 = u.pm * 256 + wr * 64 + fr, cb = u.pn * 128 + wc * 32 + 8 * fq;
#pragma unroll
        for (int ai = 0; ai < 2; ++ai)
#pragma unroll
            for (int m = 0; m < 4; ++m) {
                const int row = row0 + ai * 128 + m * 16;
                f32x4 v0, v1;
#pragma unroll
                for (int e = 0; e < 4; ++e) { v0[e] = silu_f(acc[ai][0][m][0][e]) * acc[ai][1][m][0][e]; v1[e] = silu_f(acc[ai][0][m][1][e]) * acc[ai][1][m][1][e]; }
                u32x4 w; EPI_PACK8(w, v0, v1); *(GAS u32x4*)(O + (size_t)row * DFF + cb) = w;
            }
    }
};

constexpr float QSCL = 0.10206207261596575f * 1.4426950408889634f;
struct EpiQkv {
    static constexpr bool PERM = true, AFTER_DRAIN = false;
    const GAS float*RINV, *COS, *SIN, *par; GAS bf16*QH, *KH, *VH;
    __device__ __forceinline__ void operator()(const f32x4 (&acc)[2][2][4][2], const Unit& u, int wr, int wc, int fr, int fq) const {
        asm volatile("" : "+v"(fr), "+v"(fq));
        const int row0 = u.pm * 256 + wr * 64 + fr, b8 = ((u.pm * 256) >> 12) * 8, pn = u.pn;
        if (pn >= 5) {
            const int hd = 4 * (pn - 5) + (wc >> 1);
#pragma unroll
            for (int ai = 0; ai < 2; ++ai)
#pragma unroll
                for (int m = 0; m < 4; ++m) {
                    const int row = row0 + ai * 128 + m * 16, sq = row & (SEQ - 1);
                    const float rkv = RINV[2 * row + 1];
#pragma unroll
                    for (int bj = 0; bj < 2; ++bj) {
                        const f32x4 v0 = acc[ai][bj][m][0] * rkv, v1 = acc[ai][bj][m][1] * rkv; u32x4 w; EPI_PACK8(w, v0, v1);
                        *(GAS u32x4*)(VH + ((size_t)(b8 + hd + 2 * bj) * SEQ + sq) * 64 + 32 * (wc & 1) + 8 * fq) = w;
                    }
                }
        } else if (pn == 2) {
            const f32x4 w0 = *(const GAS f32x4*)(par + P_QPW + 4 * fq), w1 = *(const GAS f32x4*)(par + P_QPW + 16 + 4 * fq);
#pragma unroll
            for (int ai = 0; ai < 2; ++ai)
#pragma unroll
                for (int m = 0; m < 4; ++m) {
                    const int row = row0 + ai * 128 + m * 16, sq = row & (SEQ - 1);
                    const float rq = RINV[2 * row];
                    const f32x4 cs = *(const GAS f32x4*)(COS + (size_t)row * 16 + 4 * fq), sn = *(const GAS f32x4*)(SIN + (size_t)row * 16 + 4 * fq);
#pragma unroll
                    for (int bj = 0; bj < 2; ++bj) {
                        f32x4 v0 = acc[ai][bj][m][0] * rq, v1 = acc[ai][bj][m][1] * rq;
                        float ss = (v0[0] * v0[0] + v0[1] * v0[1]) + (v0[2] * v0[2] + v0[3] * v0[3]) + (v1[0] * v1[0] + v1[1] * v1[1]) + (v1[2] * v1[2] + v1[3] * v1[3]);
                        ss += __shfl_xor(ss, 16); ss += __shfl_xor(ss, 32);
                        const float rn = rsqrtf(ss * (1.f / 32.f) + EPS) * QSCL;
                        v0 = v0 * rn * w0; v1 = v1 * rn * w1;
                        const f32x4 o0 = v0 * cs - v1 * sn, o1 = v1 * cs + v0 * sn;
                        u32x2 p0, p1; p0.x = cvt_pk_bf16(o0[0], o0[1]); p0.y = cvt_pk_bf16(o0[2], o0[3]); p1.x = cvt_pk_bf16(o1[0], o1[1]); p1.y = cvt_pk_bf16(o1[2], o1[3]);
                        GAS bf16* qp = QH + ((size_t)(b8 + 4 * bj + wc) * SEQ + sq) * 96 + 64 + 4 * fq;
                        *(GAS u32x2*)qp = p0; *(GAS u32x2*)(qp + 16) = p1;
                    }
                }
        } else {
            const bool isq = pn < 2; const int pnl = isq ? pn : pn - 3, hd = 4 * pnl + wc, ro = isq ? 0 : 1;
            const GAS float* wv = par + (isq ? P_QNW : P_KNW) + 8 * fq; const float scl = isq ? QSCL : 1.f;
            GAS bf16* O = isq ? QH : KH;
            f32x4 w[2][2];
#pragma unroll
            for (int bj = 0; bj < 2; ++bj)
#pragma unroll
                for (int n = 0; n < 2; ++n) w[bj][n] = *(const GAS f32x4*)(wv + 32 * bj + 4 * n);
#pragma unroll
            for (int ai = 0; ai < 2; ++ai)
#pragma unroll
                for (int m = 0; m < 4; ++m) {
                    const int row = row0 + ai * 128 + m * 16, sq = row & (SEQ - 1);
                    const float rr = RINV[2 * row + ro];
                    f32x4 v[2][2]; float ss = 0.f;
#pragma unroll
                    for (int bj = 0; bj < 2; ++bj)
#pragma unroll
                        for (int n = 0; n < 2; ++n) { v[bj][n] = acc[ai][bj][m][n] * rr; ss += (v[bj][n][0] * v[bj][n][0] + v[bj][n][1] * v[bj][n][1]) + (v[bj][n][2] * v[bj][n][2] + v[bj][n][3] * v[bj][n][3]); }
                    ss += __shfl_xor(ss, 16); ss += __shfl_xor(ss, 32);
                    const float rn = rsqrtf(ss * (1.f / 64.f) + EPS) * scl;
#pragma unroll
                    for (int bj = 0; bj < 2; ++bj) {
                        const f32x4 o0 = v[bj][0] * rn * w[bj][0], o1 = v[bj][1] * rn * w[bj][1]; u32x4 pw; EPI_PACK8(pw, o0, o1);
                        *(GAS u32x4*)(O + ((size_t)(b8 + hd) * SEQ + sq) * 96 + 32 * bj + 8 * fq) = pw;
                    }
                }
        }
    }
};

struct QkvOrder {
    pg8::StaticOrder S;
    __device__ __forceinline__ bool next(int i, Unit& u) const { return S.next(i, u); }
    __device__ __forceinline__ void a_ready(const Unit&) const {}
    __device__ __forceinline__ void done(const Unit&) const {}
    __device__ __forceinline__ int kofs(const Unit& u) const { return u.pn < 3 ? 0 : 512; }
    __device__ __forceinline__ int ntl(const Unit&, int) const { return 4; }
};
template <class Epi>
__device__ __forceinline__ void run_gemm(LAS unsigned char* lds, const GAS bf16* A, const GAS bf16* Bt, int N, int K, const Epi& E) {
    pg8::Gemm g{(const bf16*)A, (const bf16*)Bt, T, N, K}; pg8::StaticOrder S; S.init(T, N, (int)gridDim.x, (int)blockIdx.x);
    pg8::gemm_phase<Epi, pg8::StaticOrder, true, true>(lds, g, S, E);
}

__device__ __forceinline__ void phase_c(GAS unsigned char* ws, const GAS float* par, int tid, int lane, int wave) {
    const GAS bf16* QA = (const GAS bf16*)(ws + WS_QA); const GAS float* MISC = (const GAS float*)(ws + WS_MISC);
    GAS float* RINV = (GAS float*)(ws + WS_RINV); GAS bf16* KH = (GAS bf16*)(ws + WS_KH); GAS float* DT = (GAS float*)(ws + WS_DT);
    const GAS float* COS = (const GAS float*)(ws + WS_COS); const GAS float* SIN = (const GAS float*)(ws + WS_SIN);
    const int gw = blockIdx.x * NWAVES + wave, NGW = gridDim.x * NWAVES;
    const float kpw = par[P_KPW + (lane & 31)];
    const float dtb = par[P_DTB + (lane & 7)];
    for (int m0 = gw * 4; m0 < T; m0 += NGW * 4) {
        u32x2 q[4]; unsigned kv[4]; float mv[4], cs[4], sn[4];
#pragma unroll
        for (int j = 0; j < 4; ++j) {
            const int m = m0 + j;
            q[j] = *((const GAS u32x2*)(QA + (size_t)m * 512) + lane);
            kv[j] = *((const GAS unsigned*)(QA + (size_t)m * 512 + 256) + lane);
            mv[j] = MISC[(size_t)m * 64 + lane];
            cs[j] = COS[(size_t)m * 16 + (lane & 15)]; sn[j] = SIN[(size_t)m * 16 + (lane & 15)];
        }
        float sq[4], sk[4], sp[4];
#pragma unroll
        for (int j = 0; j < 4; ++j) {
            sq[j] = lo16(q[j].x) * lo16(q[j].x) + hi16(q[j].x) * hi16(q[j].x) + lo16(q[j].y) * lo16(q[j].y) + hi16(q[j].y) * hi16(q[j].y);
            sk[j] = lo16(kv[j]) * lo16(kv[j]) + hi16(kv[j]) * hi16(kv[j]);
            sp[j] = lane < 32 ? mv[j] * mv[j] : 0.f;
        }
#pragma unroll
        for (int o = 1; o < 64; o <<= 1)
#pragma unroll
            for (int j = 0; j < 4; ++j) { sq[j] += __shfl_xor(sq[j], o); sk[j] += __shfl_xor(sk[j], o); sp[j] += __shfl_xor(sp[j], o); }
#pragma unroll
        for (int j = 0; j < 4; ++j) {
            const int m = m0 + j;
            if (lane == 0) { RINV[2 * m] = rsqrtf(sq[j] * (1.f / 256.f) + EPS); RINV[2 * m + 1] = rsqrtf(sk[j] * (1.f / 128.f) + EPS); }
            const float vn = mv[j] * rsqrtf(sp[j] * (1.f / 32.f) + EPS) * kpw;
            const float partner = __shfl_xor(vn, 16);
            const float ro = (lane & 16) ? vn * cs[j] + partner * sn[j] : vn * cs[j] - partner * sn[j];
            { const bf16 rb = (bf16)f2bf(__shfl(ro, lane & 31));
              GAS bf16* kp = KH + ((size_t)((m >> 12) * 8 + (lane >> 5)) * SEQ + (m & (SEQ - 1))) * 96 + 64 + (lane & 31);
#pragma unroll
              for (int i = 0; i < 4; ++i) kp[(size_t)(2 * i) * SEQ * 96] = rb; }
            if (lane >= 32 && lane < 40) { const float v = mv[j] + dtb; DT[(size_t)m * 8 + (lane - 32)] = fmaxf(v, 0.f) + log1pf(__expf(-fabsf(v))); }
        }
    }
    const GAS bf16* XBC = (const GAS bf16*)(ws + WS_XBC); GAS bf16* XBCC = (GAS bf16*)(ws + WS_XBCC);
    for (int item = blockIdx.x * 512 + tid; item < 128 * (T / 32); item += gridDim.x * 512) {
        const int ch0 = (item & 127) * 8, t0 = (item >> 7) * 32;
        f32x4 w[4][2], bs[2];
#pragma unroll
        for (int k = 0; k < 4; ++k) { w[k][0] = *(const GAS f32x4*)(par + P_CONVW + k * 1024 + ch0); w[k][1] = *(const GAS f32x4*)(par + P_CONVW + k * 1024 + ch0 + 4); }
        bs[0] = *(const GAS f32x4*)(par + P_CONVB + ch0); bs[1] = *(const GAS f32x4*)(par + P_CONVB + ch0 + 4);
        const GAS bf16* src = XBC + (size_t)t0 * 1024 + ch0; GAS bf16* dst = XBCC + (size_t)t0 * 1024 + ch0;
        u32x4 r0 = (u32x4){0u, 0u, 0u, 0u}, r1 = r0, r2 = r0;
        if ((t0 & (SEQ - 1)) != 0) { r0 = *(const GAS u32x4*)(src - 3 * 1024); r1 = *(const GAS u32x4*)(src - 2 * 1024); r2 = *(const GAS u32x4*)(src - 1024); }
#pragma nounroll
        for (int t8 = 0; t8 < 32; t8 += 8) {
            u32x4 rr[8];
#pragma unroll
            for (int q = 0; q < 8; ++q) rr[q] = *(const GAS u32x4*)(src + (size_t)(t8 + q) * 1024);
#pragma unroll
            for (int q = 0; q < 8; ++q) {
                const int tt = t8 + q;
                const u32x4 r3 = rr[q];
                f32x4 a0 = bs[0], a1 = bs[1];
#define CV_TAP(W, R) do { a0[0] += (W)[0][0] * lo16((R).x); a0[1] += (W)[0][1] * hi16((R).x); a0[2] += (W)[0][2] * lo16((R).y); a0[3] += (W)[0][3] * hi16((R).y); \
                              a1[0] += (W)[1][0] * lo16((R).z); a1[1] += (W)[1][1] * hi16((R).z); a1[2] += (W)[1][2] * lo16((R).w); a1[3] += (W)[1][3] * hi16((R).w); } while (0)
                CV_TAP(w[0], r0); CV_TAP(w[1], r1); CV_TAP(w[2], r2); CV_TAP(w[3], r3);
#undef CV_TAP
                u32x4 o; o.x = pk2(silu_f(a0[0]), silu_f(a0[1])); o.y = pk2(silu_f(a0[2]), silu_f(a0[3])); o.z = pk2(silu_f(a1[0]), silu_f(a1[1])); o.w = pk2(silu_f(a1[2]), silu_f(a1[3]));
                *(GAS u32x4*)(dst + (size_t)tt * 1024) = o;
                r0 = r1; r1 = r2; r2 = r3;
            }
        }
    }
}

typedef float f32x16 __attribute__((ext_vector_type(16)));
typedef short s16x8 __attribute__((ext_vector_type(8)));
#define MFMA32(a, b, c) __builtin_amdgcn_mfma_f32_32x32x16_bf16((a), (b), (c), 0, 0, 0)
constexpr int AT_KROW = 208, AT_VROW = 136, AT_KBUF = 64 * AT_KROW, AT_VBUF = 64 * AT_VROW, AT_BUF = AT_KBUF + AT_VBUF;
__device__ __forceinline__ int crow16(int i, int h) { return (i & 3) + 8 * (i >> 2) + 4 * h; }

__device__ __forceinline__ void attn_unit(const GAS bf16* __restrict__ QH, const GAS bf16* __restrict__ KH, const GAS bf16* __restrict__ VH, GAS bf16* __restrict__ MIX, LAS unsigned char* lds,
                                          int bh, int qb, int tid, int lane, int wave) {
    const int r = lane & 31, h = lane >> 5;
    const int qw = qb * 256 + 32 * wave;
    s16x8 qf[6];
    { const GAS bf16* qrow = QH + ((size_t)bh * SEQ + qw + r) * 96 + 8 * h;
#pragma unroll
      for (int s = 0; s < 6; ++s) qf[s] = *(const GAS s16x8*)(qrow + 16 * s); }
    f32x16 o0, o1;
#pragma unroll
    for (int i = 0; i < 16; ++i) { o0[i] = 0.f; o1[i] = 0.f; }
    float mrun = 0.f, lsum = 0.f;
    const int ntiles = (qb + 1) * 4;
    const GAS unsigned char* kbase = (const GAS unsigned char*)(KH + (size_t)bh * SEQ * 96);
    const GAS unsigned char* vbase = (const GAS unsigned char*)(VH + (size_t)bh * SEQ * 64);
    const int ck1 = tid + 256;
    const int kd0 = (tid / 12) * AT_KROW + (tid % 12) * 16, kd1 = (ck1 / 12) * AT_KROW + (ck1 % 12) * 16;
    const int vkp = tid & 31, vc = (tid >> 5) & 7;
    u32x4 kr0, kr1, vr;
    kr0 = *(const GAS u32x4*)(kbase + (size_t)tid * 16);
    if (tid < 256) { kr1 = *(const GAS u32x4*)(vbase + (size_t)(2 * vkp * 8 + vc) * 16); vr = *(const GAS u32x4*)(vbase + (size_t)((2 * vkp + 1) * 8 + vc) * 16); }
    else { kr1 = *(const GAS u32x4*)(kbase + (size_t)ck1 * 16); vr = kr1; }
#define AT_STORE(bufp) do { LAS unsigned char* kb_ = (bufp); LAS unsigned char* vb_ = kb_ + AT_KBUF; \
        *(LAS u32x4*)(kb_ + kd0) = kr0; \
        if (tid < 256) { LAS unsigned* vt_ = (LAS unsigned*)(vb_ + (8 * vc) * AT_VROW + vkp * 4); TP_WRITE(vt_, AT_VROW / 4, kr1, vr); } \
        else *(LAS u32x4*)(kb_ + kd1) = kr1; } while (0)
    AT_STORE(lds);
    for (int jt = 0; jt < ntiles; ++jt) {
        __syncthreads();
        const int k0 = jt * 64;
        const bool more = jt + 1 < ntiles;
        if (more) {
            const GAS unsigned char* kt = kbase + (size_t)(k0 + 64) * 192; const GAS unsigned char* vt = vbase + (size_t)(k0 + 64) * 128;
            kr0 = *(const GAS u32x4*)(kt + (size_t)tid * 16);
            if (tid < 256) { kr1 = *(const GAS u32x4*)(vt + (size_t)(2 * vkp * 8 + vc) * 16); vr = *(const GAS u32x4*)(vt + (size_t)((2 * vkp + 1) * 8 + vc) * 16); }
            else kr1 = *(const GAS u32x4*)(kt + (size_t)ck1 * 16);
        }
        LAS unsigned char* kb = lds + (jt & 1) * AT_BUF; LAS unsigned char* vb = kb + AT_KBUF;
        if (k0 <= qw + 31) {
            f32x16 s0, s1;
            { const float ninit = -mrun;
#pragma unroll
              for (int i = 0; i < 16; ++i) { s0[i] = ninit; s1[i] = ninit; } }
#pragma unroll
            for (int s = 0; s < 6; ++s) {
                const s16x8 ka = *(const LAS s16x8*)(kb + r * AT_KROW + (16 * s + 8 * h) * 2);
                const s16x8 kc = *(const LAS s16x8*)(kb + (32 + r) * AT_KROW + (16 * s + 8 * h) * 2);
                s0 = MFMA32(ka, qf[s], s0); s1 = MFMA32(kc, qf[s], s1);
            }
            if (k0 + 63 > qw) {
                const int qi = qw + r - k0;
#pragma unroll
                for (int i = 0; i < 16; ++i) { const int kk = crow16(i, h); if (kk > qi) s0[i] = -1e30f; if (kk + 32 > qi) s1[i] = -1e30f; }
            }
            float mx = s0[0];
#pragma unroll
            for (int i = 1; i < 16; ++i) mx = fmaxf(mx, s0[i]);
#pragma unroll
            for (int i = 0; i < 16; ++i) mx = fmaxf(mx, s1[i]);
            mx = fmaxf(mx, __shfl_xor(mx, 32));
            if (jt == 0 || __builtin_amdgcn_ballot_w64(mx > 8.0f) != 0ull) {
                const float d = (jt == 0) ? mx : fmaxf(mx, 0.f);
                const float al = (jt == 0) ? 0.f : __builtin_amdgcn_exp2f(-d);
                mrun += d; lsum *= al;
#pragma unroll
                for (int i = 0; i < 16; ++i) { o0[i] *= al; o1[i] *= al; s0[i] -= d; s1[i] -= d; }
            }
            float ps = 0.f;
#pragma unroll
            for (int i = 0; i < 16; ++i) { s0[i] = __builtin_amdgcn_exp2f(s0[i]); s1[i] = __builtin_amdgcn_exp2f(s1[i]); ps += s0[i] + s1[i]; }
            lsum += ps;
#pragma unroll
            for (int ks = 0; ks < 4; ++ks) {
                u32x4 pw;
                if (ks == 0) { pw.x = pk2(s0[0], s0[1]); pw.y = pk2(s0[2], s0[3]); pw.z = pk2(s0[4], s0[5]); pw.w = pk2(s0[6], s0[7]); }
                else if (ks == 1) { pw.x = pk2(s0[8], s0[9]); pw.y = pk2(s0[10], s0[11]); pw.z = pk2(s0[12], s0[13]); pw.w = pk2(s0[14], s0[15]); }
                else if (ks == 2) { pw.x = pk2(s1[0], s1[1]); pw.y = pk2(s1[2], s1[3]); pw.z = pk2(s1[4], s1[5]); pw.w = pk2(s1[6], s1[7]); }
                else { pw.x = pk2(s1[8], s1[9]); pw.y = pk2(s1[10], s1[11]); pw.z = pk2(s1[12], s1[13]); pw.w = pk2(s1[14], s1[15]); }
                const s16x8 pf = __builtin_bit_cast(s16x8, pw);
                const int keyb = 32 * (ks >> 1) + 16 * (ks & 1) + 4 * h;
                u32x4 va, vb2;
                { const u32x2 lo = *(const LAS u32x2*)(vb + r * AT_VROW + keyb * 2), hi = *(const LAS u32x2*)(vb + r * AT_VROW + (keyb + 8) * 2); va.x = lo.x; va.y = lo.y; va.z = hi.x; va.w = hi.y; }
                { const u32x2 lo = *(const LAS u32x2*)(vb + (32 + r) * AT_VROW + keyb * 2), hi = *(const LAS u32x2*)(vb + (32 + r) * AT_VROW + (keyb + 8) * 2); vb2.x = lo.x; vb2.y = lo.y; vb2.z = hi.x; vb2.w = hi.y; }
                o0 = MFMA32(__builtin_bit_cast(s16x8, va), pf, o0);
                o1 = MFMA32(__builtin_bit_cast(s16x8, vb2), pf, o1);
            }
        }
        if (more) AT_STORE(lds + ((jt + 1) & 1) * AT_BUF);
    }
#undef AT_STORE
    __syncthreads();
    const float inv = 1.f / (lsum + __shfl_xor(lsum, 32));
    const int b = bh >> 3, hh = bh & 7;
    GAS bf16* orow = MIX + ((size_t)b * SEQ + qw + r) * 1024 + hh * 64 + 4 * h;
#pragma unroll
    for (int g = 0; g < 4; ++g) {
        u32x2 w0, w1;
        w0.x = pk2(o0[4 * g] * inv, o0[4 * g + 1] * inv); w0.y = pk2(o0[4 * g + 2] * inv, o0[4 * g + 3] * inv);
        w1.x = pk2(o1[4 * g] * inv, o1[4 * g + 1] * inv); w1.y = pk2(o1[4 * g + 2] * inv, o1[4 * g + 3] * inv);
        *(GAS u32x2*)(orow + 8 * g) = w0; *(GAS u32x2*)(orow + 32 + 8 * g) = w1;
    }
}
__device__ __forceinline__ void phase_attn(GAS unsigned char* ws, LAS unsigned char* lds, int tid, int lane, int wave) {
    const GAS bf16* QH = (const GAS bf16*)(ws + WS_QH); const GAS bf16* KH = (const GAS bf16*)(ws + WS_KH); const GAS bf16* VH = (const GAS bf16*)(ws + WS_VH);
    GAS bf16* MIX = (GAS bf16*)(ws + WS_MIX);
    const int c = blockIdx.x, G = gridDim.x;
    const int vcu = (G % 8 == 0) ? (c % 8) * (G / 8) + c / 8 : c;
    for (int item = vcu; item < 256; item += G) {
        const int bh = item >> 2, j = item & 3;
        for (int u = 0; u < 4; ++u) {
            const int qb = (u == 0) ? 15 - j : (u == 1) ? 8 + j : (u == 2) ? 7 - j : j;
            attn_unit(QH, KH, VH, MIX, lds, bh, qb, tid, lane, wave);
        }
    }
}

constexpr int SS_ROW = 272;
constexpr int SS_BT = 0, SS_XT = 128 * SS_ROW, SS_TAB = SS_XT + 256 * SS_ROW;
__device__ __forceinline__ void ssd_tables(const GAS float* __restrict__ DT, const GAS float* __restrict__ par, LAS float* tab, int t0, int g, int tid, float& dtv_out, float& acs_out, float& aend_out) {
    const int hl = tid >> 7, s = tid & 127, h = 4 * g + hl, ln = tid & 63;
    const float dtv = DT[(size_t)(t0 + s) * 8 + h], av = -__expf(par[P_ALOG + h]);
    float acs = dtv * av;
#pragma unroll
    for (int o = 1; o < 64; o <<= 1) { const float up = __shfl_up(acs, o); if (ln >= o) acs += up; }
    if (ln == 63) tab[tid >> 6] = acs;
    __syncthreads();
    const float lo_tot = tab[2 * hl], hi_tot = tab[2 * hl + 1];
    if (s >= 64) acs += lo_tot;
    const float aend = lo_tot + hi_tot;
    __syncthreads();
    tab[512 + tid] = acs; tab[1024 + tid] = dtv;
    dtv_out = dtv; acs_out = acs; aend_out = aend;
    __syncthreads();
}
__device__ __forceinline__ void ssd_pass_a(GAS unsigned char* ws, const GAS float* par, LAS unsigned char* lds, unsigned* uctr, int tid, int lane, int wave) {
    const GAS bf16* XC = (const GAS bf16*)(ws + WS_XBCC); const GAS float* DT = (const GAS float*)(ws + WS_DT); GAS bf16* ST = (GAS bf16*)(ws + WS_ST); GAS float* CDEC = (GAS float*)(ws + WS_CDEC);
    LAS float* tab = (LAS float*)(lds + SS_TAB);
    for (int u = blockIdx.x; u < 512; ) {
        asm volatile("" : "+v"(tid), "+v"(lane));
        const int r = lane & 31, h2 = lane >> 5;
        const int g = u & 1, c = (u >> 1) & 31, b = u >> 6, t0 = b * SEQ + c * 128;
        u32x4 bva[2], bvb[2], xva[4], xvb[4];
#pragma unroll
        for (int i = 0; i < 2; ++i) {
            const int id = tid + 512 * i, sp = id & 63, nc = id >> 6;
            const GAS bf16* src = XC + (size_t)(t0 + 2 * sp) * 1024 + 512 + g * 128 + nc * 8;
            bva[i] = *(const GAS u32x4*)src; bvb[i] = *(const GAS u32x4*)(src + 1024);
        }
#pragma unroll
        for (int i = 0; i < 4; ++i) {
            const int id = tid + 512 * i, sp = id & 63, pc = id >> 6;
            const GAS bf16* src = XC + (size_t)(t0 + 2 * sp) * 1024 + g * 256 + pc * 8;
            xva[i] = *(const GAS u32x4*)src; xvb[i] = *(const GAS u32x4*)(src + 1024);
        }
        float dtv, acs, aend;
        ssd_tables(DT, par, tab, t0, g, tid, dtv, acs, aend);
        tab[tid] = dtv * __expf(aend - acs);
        if ((tid & 127) == 127) CDEC[(size_t)(b * 32 + c) * 8 + 4 * g + (tid >> 7)] = __expf(acs);
#pragma unroll
        for (int i = 0; i < 2; ++i) {
            const int id = tid + 512 * i, sp = id & 63, nc = id >> 6;
            LAS unsigned* d = (LAS unsigned*)(lds + SS_BT + (8 * nc) * SS_ROW + sp * 4);
            TP_WRITE(d, SS_ROW / 4, bva[i], bvb[i]);
        }
        __syncthreads();
#pragma unroll
        for (int i = 0; i < 4; ++i) {
            const int id = tid + 512 * i, sp = id & 63, pc = id >> 6;
            const u32x4 va = xva[i], vb = xvb[i];
            const float sa = tab[(pc >> 3) * 128 + 2 * sp], sb2 = tab[(pc >> 3) * 128 + 2 * sp + 1];
            LAS unsigned* d = (LAS unsigned*)(lds + SS_XT + (8 * pc) * SS_ROW + sp * 4);
            d[0 * (SS_ROW / 4)] = pk2(lo16(va.x) * sa, lo16(vb.x) * sb2); d[1 * (SS_ROW / 4)] = pk2(hi16(va.x) * sa, hi16(vb.x) * sb2);
            d[2 * (SS_ROW / 4)] = pk2(lo16(va.y) * sa, lo16(vb.y) * sb2); d[3 * (SS_ROW / 4)] = pk2(hi16(va.y) * sa, hi16(vb.y) * sb2);
            d[4 * (SS_ROW / 4)] = pk2(lo16(va.z) * sa, lo16(vb.z) * sb2); d[5 * (SS_ROW / 4)] = pk2(hi16(va.z) * sa, hi16(vb.z) * sb2);
            d[6 * (SS_ROW / 4)] = pk2(lo16(va.w) * sa, lo16(vb.w) * sb2); d[7 * (SS_ROW / 4)] = pk2(hi16(va.w) * sa, hi16(vb.w) * sb2);
        }
        __syncthreads();
        f32x16 acc[4];
#pragma unroll
        for (int nb = 0; nb < 4; ++nb)
#pragma unroll
            for (int i = 0; i < 16; ++i) acc[nb][i] = 0.f;
        __builtin_amdgcn_s_setprio(1);
#pragma unroll
        for (int st = 0; st < 8; ++st) {
            const s16x8 xb = *(const LAS s16x8*)(lds + SS_XT + (32 * wave + r) * SS_ROW + (16 * st + 8 * h2) * 2);
#pragma unroll
            for (int nb = 0; nb < 4; ++nb) {
                const s16x8 ba = *(const LAS s16x8*)(lds + SS_BT + (32 * nb + r) * SS_ROW + (16 * st + 8 * h2) * 2);
                acc[nb] = MFMA32(ba, xb, acc[nb]);
            }
        }
        __builtin_amdgcn_s_setprio(0);
        GAS bf16* sp = ST + ((size_t)((b * 32 + c) * 8 + 4 * g + (wave >> 1)) * 64 + 32 * (wave & 1) + r) * 128 + 4 * h2;
#pragma unroll
        for (int nb = 0; nb < 4; ++nb)
#pragma unroll
            for (int q = 0; q < 4; ++q) { u32x2 w; w.x = pk2(acc[nb][4 * q], acc[nb][4 * q + 1]); w.y = pk2(acc[nb][4 * q + 2], acc[nb][4 * q + 3]); *(GAS u32x2*)(sp + 32 * nb + 8 * q) = w; }
        { LAS volatile int* uslot = (LAS volatile int*)(lds + 131072 + 512);
          if (tid == 0) *uslot = (int)gridDim.x + (int)__hip_atomic_fetch_add(uctr, 1u, __ATOMIC_RELAXED, __HIP_MEMORY_SCOPE_AGENT);
          __syncthreads();
          u = __builtin_amdgcn_readfirstlane(*uslot); }
    }
}
__device__ __forceinline__ void ssd_pass_b(GAS unsigned char* ws, int tid) {
    GAS bf16* ST = (GAS bf16*)(ws + WS_ST); const GAS float* CDEC = (const GAS float*)(ws + WS_CDEC);
    for (int idx = blockIdx.x * 512 + tid; idx < 64 * 2048; idx += gridDim.x * 512) {
        const int bh = idx >> 11, off = (idx & 2047) * 4, b = bh >> 3, h = bh & 7;
        GAS bf16* base = ST + (size_t)(b * 32 * 8 + h) * 8192 + off;
        u32x2 v[32]; float d[32];
#pragma unroll
        for (int c = 0; c < 32; ++c) { v[c] = *(const GAS u32x2*)(base + (size_t)c * 8 * 8192); d[c] = CDEC[(b * 32 + c) * 8 + h]; }
        float c0 = 0.f, c1 = 0.f, c2 = 0.f, c3 = 0.f;
#pragma unroll
        for (int c = 0; c < 32; ++c) {
            u32x2 o; o.x = pk2(c0, c1); o.y = pk2(c2, c3); *(GAS u32x2*)(base + (size_t)c * 8 * 8192) = o;
            c0 = d[c] * c0 + lo16(v[c].x); c1 = d[c] * c1 + hi16(v[c].x); c2 = d[c] * c2 + lo16(v[c].y); c3 = d[c] * c3 + hi16(v[c].y);
        }
    }
}
__device__ __forceinline__ void ssd_pass_c(GAS unsigned char* ws, const GAS float* par, LAS unsigned char* lds, int tid, int lane, int wave) {
    const GAS bf16* XC = (const GAS bf16*)(ws + WS_XBCC); const GAS float* DT = (const GAS float*)(ws + WS_DT); const GAS bf16* ST = (const GAS bf16*)(ws + WS_ST); const GAS bf16* Z = (const GAS bf16*)(ws + WS_Z); GAS bf16* MIX = (GAS bf16*)(ws + WS_MIX);
    LAS float* tab = (LAS float*)(lds + SS_TAB); LAS float* red = tab + 1536;
    const int lb = wave & 3, hp = wave >> 2;
    for (int u = blockIdx.x; u < 512; u += gridDim.x) {
        asm volatile("" : "+v"(tid), "+v"(lane));
        const int r = lane & 31, h2 = lane >> 5;
        const int g = u & 1, c = (u >> 1) & 31, b = u >> 6, t0 = b * SEQ + c * 128;
        const int l = 32 * lb + r;
        s16x8 cf[8];
        { const GAS bf16* crow_ = XC + (size_t)(t0 + l) * 1024 + 768 + g * 128 + 8 * h2;
#pragma unroll
          for (int st = 0; st < 8; ++st) cf[st] = *(const GAS s16x8*)(crow_ + 16 * st); }
        s16x8 pva[8], pvb[8], pvc[8], pvd[8];
        { const GAS bf16* pv = ST + ((size_t)((b * 32 + c) * 8 + 4 * g + 2 * hp) * 64 + r) * 128 + 8 * h2;
#pragma unroll
          for (int st = 0; st < 8; ++st) { pva[st] = *(const GAS s16x8*)(pv + 16 * st); pvb[st] = *(const GAS s16x8*)(pv + 32 * 128 + 16 * st);
                                           pvc[st] = *(const GAS s16x8*)(pv + 64 * 128 + 16 * st); pvd[st] = *(const GAS s16x8*)(pv + 96 * 128 + 16 * st); } }
        u32x4 bv[4], xva[4], xvb[4];
#pragma unroll
        for (int i = 0; i < 4; ++i) {
            const int id = tid + 512 * i, s = id >> 4, nc = id & 15;
            bv[i] = *(const GAS u32x4*)(XC + (size_t)(t0 + s) * 1024 + 512 + g * 128 + nc * 8);
        }
#pragma unroll
        for (int i = 0; i < 4; ++i) {
            const int id = tid + 512 * i, sp = id & 63, pc = id >> 6;
            const GAS bf16* src = XC + (size_t)(t0 + 2 * sp) * 1024 + g * 256 + pc * 8;
            xva[i] = *(const GAS u32x4*)src; xvb[i] = *(const GAS u32x4*)(src + 1024);
        }
        float dtv, acs, aend;
        ssd_tables(DT, par, tab, t0, g, tid, dtv, acs, aend);
#pragma unroll
        for (int i = 0; i < 4; ++i) { const int id = tid + 512 * i, s = id >> 4, nc = id & 15; *(LAS u32x4*)(lds + SS_BT + s * SS_ROW + nc * 16) = bv[i]; }
#pragma unroll
        for (int i = 0; i < 4; ++i) {
            const int id = tid + 512 * i, sp = id & 63, pc = id >> 6;
            LAS unsigned* d = (LAS unsigned*)(lds + SS_XT + (8 * pc) * SS_ROW + sp * 4);
            TP_WRITE(d, SS_ROW / 4, xva[i], xvb[i]);
        }
        __syncthreads();
        f32x16 ya0, ya1, yb0, yb1; float ssq = 0.f;
#pragma unroll
        for (int i = 0; i < 16; ++i) { ya0[i] = 0.f; ya1[i] = 0.f; yb0[i] = 0.f; yb1[i] = 0.f; }
        __builtin_amdgcn_s_setprio(1);
#pragma unroll
        for (int st = 0; st < 8; ++st) { ya0 = MFMA32(pva[st], cf[st], ya0); ya1 = MFMA32(pvb[st], cf[st], ya1); yb0 = MFMA32(pvc[st], cf[st], yb0); yb1 = MFMA32(pvd[st], cf[st], yb1); }
        __builtin_amdgcn_s_setprio(0);
        { const float ea = __expf(tab[512 + (2 * hp) * 128 + l]), eb = __expf(tab[512 + (2 * hp + 1) * 128 + l]);
#pragma unroll
          for (int i = 0; i < 16; ++i) { ya0[i] *= ea; ya1[i] *= ea; yb0[i] *= eb; yb1[i] *= eb; } }
        u32x2 xq[2][8], zq[2][8];
#define SS_LOAD_XZ(hd) do { const int hh_ = 4 * g + 2 * hp + (hd); \
            const GAS bf16* xrow = XC + (size_t)(t0 + l) * 1024 + hh_ * 64 + 4 * h2; const GAS bf16* zrow = Z + (size_t)(t0 + l) * 512 + hh_ * 64 + 4 * h2; \
            _Pragma("unroll") for (int q = 0; q < 4; ++q) { xq[hd][2 * q] = *(const GAS u32x2*)(xrow + 8 * q); xq[hd][2 * q + 1] = *(const GAS u32x2*)(xrow + 32 + 8 * q); \
                                          zq[hd][2 * q] = *(const GAS u32x2*)(zrow + 8 * q); zq[hd][2 * q + 1] = *(const GAS u32x2*)(zrow + 32 + 8 * q); } } while (0)
        SS_LOAD_XZ(0);
        f32x16 gt[4];
        __builtin_amdgcn_s_setprio(1);
#pragma unroll
        for (int sb = 0; sb < 4; ++sb) {
#pragma unroll
            for (int i = 0; i < 16; ++i) gt[sb][i] = 0.f;
            if (sb <= lb) {
#pragma unroll
                for (int st = 0; st < 8; ++st) {
                    const s16x8 ba = *(const LAS s16x8*)(lds + SS_BT + (32 * sb + r) * SS_ROW + (16 * st + 8 * h2) * 2);
                    gt[sb] = MFMA32(ba, cf[st], gt[sb]);
                }
            }
        }
        __builtin_amdgcn_s_setprio(0);
#pragma unroll
        for (int hd = 0; hd < 2; ++hd) {
            const int hl = 2 * hp + hd, hh = 4 * g + hl;
            const float acs_l = tab[512 + hl * 128 + l];
            f32x16& y0 = hd == 0 ? ya0 : yb0; f32x16& y1 = hd == 0 ? ya1 : yb1;
#pragma unroll
            for (int sb = 0; sb < 4; ++sb) {
                if (sb <= lb) {
                    float w[16];
                    int lim = (sb == lb) ? r : 64;
                    asm volatile("" : "+v"(lim));
#pragma unroll
                    for (int i = 0; i < 16; ++i) {
                        const int s = 32 * sb + crow16(i, h2);
                        const float as = tab[512 + hl * 128 + s], ds = tab[1024 + hl * 128 + s];
                        const float keep = (crow16(i, h2) <= lim) ? ds : 0.f;
                        w[i] = gt[sb][i] * __expf(fminf(acs_l - as, 0.f)) * keep;
                    }
#pragma unroll
                    for (int ks = 0; ks < 2; ++ks) {
                        u32x4 pw; pw.x = pk2(w[8 * ks], w[8 * ks + 1]); pw.y = pk2(w[8 * ks + 2], w[8 * ks + 3]); pw.z = pk2(w[8 * ks + 4], w[8 * ks + 5]); pw.w = pk2(w[8 * ks + 6], w[8 * ks + 7]);
                        const s16x8 pf = __builtin_bit_cast(s16x8, pw);
                        const int keyb = 32 * sb + 16 * ks + 4 * h2;
                        u32x4 va, vb;
                        { LAS unsigned char* xr = lds + SS_XT + (hl * 64 + r) * SS_ROW; const u32x2 lo = *(const LAS u32x2*)(xr + keyb * 2), hi = *(const LAS u32x2*)(xr + (keyb + 8) * 2); va.x = lo.x; va.y = lo.y; va.z = hi.x; va.w = hi.y; }
                        { LAS unsigned char* xr = lds + SS_XT + (hl * 64 + 32 + r) * SS_ROW; const u32x2 lo = *(const LAS u32x2*)(xr + keyb * 2), hi = *(const LAS u32x2*)(xr + (keyb + 8) * 2); vb.x = lo.x; vb.y = lo.y; vb.z = hi.x; vb.w = hi.y; }
                        y0 = MFMA32(__builtin_bit_cast(s16x8, va), pf, y0);
                        y1 = MFMA32(__builtin_bit_cast(s16x8, vb), pf, y1);
                    }
                }
            }
            if (hd == 0) SS_LOAD_XZ(1);
            const float dsk = par[P_DSKIP + hh];
#pragma unroll
            for (int q = 0; q < 4; ++q) {
                const u32x2 x0 = xq[hd][2 * q], x1 = xq[hd][2 * q + 1], z0 = zq[hd][2 * q], z1 = zq[hd][2 * q + 1];
                y0[4 * q] = (y0[4 * q] + dsk * lo16(x0.x)) * silu_f(lo16(z0.x)); y0[4 * q + 1] = (y0[4 * q + 1] + dsk * hi16(x0.x)) * silu_f(hi16(z0.x));
                y0[4 * q + 2] = (y0[4 * q + 2] + dsk * lo16(x0.y)) * silu_f(lo16(z0.y)); y0[4 * q + 3] = (y0[4 * q + 3] + dsk * hi16(x0.y)) * silu_f(hi16(z0.y));
                y1[4 * q] = (y1[4 * q] + dsk * lo16(x1.x)) * silu_f(lo16(z1.x)); y1[4 * q + 1] = (y1[4 * q + 1] + dsk * hi16(x1.x)) * silu_f(hi16(z1.x));
                y1[4 * q + 2] = (y1[4 * q + 2] + dsk * lo16(x1.y)) * silu_f(lo16(z1.y)); y1[4 * q + 3] = (y1[4 * q + 3] + dsk * hi16(x1.y)) * silu_f(hi16(z1.y));
            }
#pragma unroll
            for (int i = 0; i < 16; ++i) { ssq += y0[i] * y0[i] + y1[i] * y1[i]; }
        }
#undef SS_LOAD_XZ
        ssq += __shfl_xor(ssq, 32);
        if (h2 == 0) red[hp * 128 + l] = ssq;
        __syncthreads();
        {
            const float rn = rsqrtf((red[l] + red[128 + l]) * (1.f / 256.f) + EPS);
#pragma unroll
            for (int hd = 0; hd < 2; ++hd) {
                const int hl = 2 * hp + hd;
                const GAS float* nw = par + P_SSDNW + g * 256 + hl * 64 + 4 * h2;
                GAS bf16* mrow = MIX + (size_t)(t0 + l) * 1024 + 512 + g * 256 + hl * 64 + 4 * h2;
#pragma unroll
                for (int q = 0; q < 4; ++q) {
                    const f32x4 w0 = *(const GAS f32x4*)(nw + 8 * q), w1 = *(const GAS f32x4*)(nw + 32 + 8 * q);
                    const f32x16& u0 = hd == 0 ? ya0 : yb0; const f32x16& u1 = hd == 0 ? ya1 : yb1;
                    u32x2 o0, o1;
                    o0.x = pk2(u0[4 * q] * rn * w0[0], u0[4 * q + 1] * rn * w0[1]); o0.y = pk2(u0[4 * q + 2] * rn * w0[2], u0[4 * q + 3] * rn * w0[3]);
                    o1.x = pk2(u1[4 * q] * rn * w1[0], u1[4 * q + 1] * rn * w1[1]); o1.y = pk2(u1[4 * q + 2] * rn * w1[2], u1[4 * q + 3] * rn * w1[3]);
                    *(GAS u32x2*)(mrow + 8 * q) = o0; *(GAS u32x2*)(mrow + 32 + 8 * q) = o1;
                }
            }
        }
        __syncthreads();
    }
}

#define XB_TMO      128
#define XB_XCNT(j)  (256  + 64 * (j))
#define XB_XSUB(j)  (1280 + 64 * (j))
#define XB_XGEN(j)  (2304 + 64 * (j))
#define XB_TOP      3328
#define XB_TOPGEN   3392
#define XCD_BAR_WORDS 3456
#define XB_SPIN_CAP (1u << 18)

__device__ __forceinline__ unsigned xb_ld(unsigned* p)              { return __hip_atomic_load(p, __ATOMIC_RELAXED, __HIP_MEMORY_SCOPE_AGENT); }
__device__ __forceinline__ unsigned xb_add(unsigned* p, unsigned v) { return __hip_atomic_fetch_add(p, v, __ATOMIC_RELAXED, __HIP_MEMORY_SCOPE_AGENT); }
__device__ __forceinline__ unsigned xb_xcc_id() { return (unsigned)__builtin_amdgcn_s_getreg((3 << 11) | 20) & 0xFu; }
#define XB_SPIN(cond, bar) do { unsigned _sp = 0; while (cond) { __builtin_amdgcn_s_sleep(1); \
    if ((++_sp & 255u) == 0u) { if (xb_ld(&(bar)[XB_TMO])) break; if (_sp > XB_SPIN_CAP) { atomicAdd(&(bar)[XB_TMO], 1u); break; } } } } while (0)

struct XcdBarrier {
    unsigned* bar; unsigned x;
    volatile LAS unsigned* st;
};

__device__ __forceinline__ XcdBarrier xcd_barrier_post(unsigned* bar, volatile LAS unsigned* st) {
    XcdBarrier b; b.bar = bar; b.x = xb_xcc_id(); b.st = st;
    if (threadIdx.x == 0) (void)xb_add(&bar[XB_XCNT(b.x)], 1u);
    return b;
}
__device__ __forceinline__ void xcd_barrier_complete(unsigned* bar, unsigned x, unsigned& nloc, unsigned& nx) {
    const unsigned G = gridDim.x * gridDim.y * gridDim.z;
    unsigned sum, cnt, mine, sp = 0u;
    for (;;) {
        sum = 0u; cnt = 0u; mine = 0u;
#pragma unroll
        for (unsigned j = 0; j < 16; ++j) { const unsigned c = xb_ld(&bar[XB_XCNT(j)]); sum += c; cnt += (c > 0u) ? 1u : 0u; mine = (j == x) ? c : mine; }
        if (sum == G) break;
        __builtin_amdgcn_s_sleep(1);
        if ((++sp & 255u) == 0u) { if (xb_ld(&bar[XB_TMO])) break; if (sp > XB_SPIN_CAP) { atomicAdd(&bar[XB_TMO], 1u); break; } }
    }
    nloc = mine > 0u ? mine : 1u; nx = cnt > 0u ? cnt : 1u;
}

__device__ __forceinline__ void xcd_barrier(const XcdBarrier& b) {
    asm volatile("s_waitcnt vmcnt(0)" ::: "memory");
    __syncthreads();
    if (threadIdx.x == 0) {
        unsigned* bar = b.bar; asm volatile("" : "+s"(bar));
        __builtin_amdgcn_s_waitcnt(0);
        unsigned nloc = b.st[0], nx = b.st[1];
        if (nloc == 0u) { xcd_barrier_complete(bar, b.x, nloc, nx); b.st[0] = nloc; b.st[1] = nx; }
        const unsigned old = xb_add(&bar[XB_XSUB(b.x)], 1u);
        const unsigned gen = old / nloc;
        if (old + 1u == (gen + 1u) * nloc) {
            __builtin_amdgcn_fence(__ATOMIC_RELEASE, "agent");
            asm volatile("s_waitcnt vmcnt(0)" ::: "memory");
            const unsigned og = xb_add(&bar[XB_TOP], 1u);
            const unsigned tg = og / nx;
            if (og + 1u == (tg + 1u) * nx) xb_add(&bar[XB_TOPGEN], 1u);
            else XB_SPIN(xb_ld(&bar[XB_TOPGEN]) == tg, bar);
            __builtin_amdgcn_fence(__ATOMIC_ACQUIRE, "agent");
            xb_add(&bar[XB_XGEN(b.x)], 1u);
            asm volatile("s_waitcnt vmcnt(0)" ::: "memory");
        } else {
            XB_SPIN(xb_ld(&bar[XB_XGEN(b.x)]) == gen, bar);
            __builtin_amdgcn_fence(__ATOMIC_ACQUIRE, "agent");
            asm volatile("s_waitcnt vmcnt(0)" ::: "memory");
        }
    }
    __syncthreads();
}


#define GSYNC() xcd_barrier(xbar)
#define PH_PTRS GAS unsigned char* ws = ws0; asm volatile("" : "+s"(ws)); const GAS float* modl = (const GAS float*)(ws + WS_MOD) + (size_t)l * 8 * 6144; const GAS unsigned char* wl = ws + WS_W + (size_t)l * WL_STRIDE; \
    const GAS float* par = (const GAS float*)(ws + WS_PAR) + (size_t)l * P_STRIDE; (void)modl; (void)wl; (void)par;
#define PH_IDS int tid = threadIdx.x; asm volatile("" : "+v"(tid)); const int lane = tid & 63, wave = __builtin_amdgcn_readfirstlane(tid >> 6); (void)lane; (void)wave;
__device__ __forceinline__ void layer_body(const Args& a, GAS unsigned char* ws0, LAS unsigned char* lds, const XcdBarrier& xbar, const int l) {
        const GAS float* xf32 = as_global(a.in[I_X]);
        GAS float* const outp = as_global(a.out);
        if (l == 0) { PH_PTRS PH_IDS phase_norm<false>(xf32, par + P_N1W, modl, 0, 1024, (GAS bf16*)(ws + WS_H), lane, wave); }
        else        { PH_PTRS PH_IDS phase_norm<true>(outp, par + P_N1W, modl, 0, 1024, (GAS bf16*)(ws + WS_H), lane, wave); }
        GSYNC();
        { PH_PTRS EpiIn E{(GAS bf16*)(ws + WS_QA), (GAS bf16*)(ws + WS_Z), (GAS bf16*)(ws + WS_XBC), (GAS float*)(ws + WS_MISC)};
          run_gemm(lds, (const GAS bf16*)(ws + WS_H), (const GAS bf16*)(wl + WO_IN), DINP, D, E); }
        GSYNC();
        { PH_PTRS PH_IDS phase_c(ws, par, tid, lane, wave); }
        GSYNC();
        { PH_PTRS EpiQkv E{(const GAS float*)(ws + WS_RINV), (const GAS float*)(ws + WS_COS), (const GAS float*)(ws + WS_SIN), par, (GAS bf16*)(ws + WS_QH), (GAS bf16*)(ws + WS_KH), (GAS bf16*)(ws + WS_VH)};
          pg8::Gemm gq{(const bf16*)(ws + WS_QA), (const bf16*)(wl + WO_Q), T, NQ + NKV, 512}; QkvOrder S; S.S.init(T, NQ + NKV, (int)gridDim.x, (int)blockIdx.x);
          pg8::gemm_phase<EpiQkv, QkvOrder, true, true>(lds, gq, S, E); }
        __syncthreads();
        { PH_PTRS PH_IDS ssd_pass_a(ws, par, lds, (unsigned*)(ws + WS_CTL + 16384) + 64 * l, tid, lane, wave); }
        GSYNC();
        { PH_PTRS PH_IDS phase_attn(ws, lds, tid, lane, wave); }
        { PH_PTRS PH_IDS ssd_pass_b(ws, tid); }
        GSYNC();
        { PH_PTRS PH_IDS ssd_pass_c(ws, par, lds, tid, lane, wave); }
        GSYNC();
        if (l == 0) { PH_PTRS EpiResT<false, true> E{xf32, ws + WS_X1, modl + 2048}; run_gemm(lds, (const GAS bf16*)(ws + WS_MIX), (const GAS bf16*)(wl + WO_OUT), D, D, E); }
        else        { PH_PTRS EpiResT<true, true> E{outp, ws + WS_X1, modl + 2048}; run_gemm(lds, (const GAS bf16*)(ws + WS_MIX), (const GAS bf16*)(wl + WO_OUT), D, D, E); }
        GSYNC();
        { PH_PTRS PH_IDS phase_norm<true>(ws + WS_X1, par + P_N2W, modl, 3072, 4096, (GAS bf16*)(ws + WS_H), lane, wave); }
        GSYNC();
        { PH_PTRS EpiSwiglu E{(GAS bf16*)(ws + WS_ACT)}; run_gemm(lds, (const GAS bf16*)(ws + WS_H), (const GAS bf16*)(wl + WO_GU), NGU, D, E); }
        GSYNC();
        if (l + 1 < DEPTH) { PH_PTRS EpiResT<true, true> E2{ws + WS_X1, outp, modl + 5120}; run_gemm(lds, (const GAS bf16*)(ws + WS_ACT), (const GAS bf16*)(wl + WO_D), D, DFF, E2); }
        else               { PH_PTRS EpiResT<true, false> E2{ws + WS_X1, outp, modl + 5120}; run_gemm(lds, (const GAS bf16*)(ws + WS_ACT), (const GAS bf16*)(wl + WO_D), D, DFF, E2); }
        if (l + 1 < DEPTH) GSYNC();
}

__global__ void __launch_bounds__(NWAVES * 64, 2) mega_fwd(Args a) {
    extern __shared__ __attribute__((aligned(16))) unsigned char lds_raw[];
    LAS unsigned char* lds = (LAS unsigned char*)lds_raw;
    cg::grid_group grid = cg::this_grid();
    GAS unsigned char* const ws0 = as_global(a.ws);
    GAS unsigned char* ws = ws0;
    volatile LAS unsigned* xst = (volatile LAS unsigned*)(lds + 131072 + 64);
    if (threadIdx.x < 4) xst[threadIdx.x] = 0u;
    __syncthreads();
    const XcdBarrier xbar = xcd_barrier_post((unsigned*)(ws + WS_CTL), xst);
    { PH_IDS
    phase_prep(a, lds, tid, lane, wave); }
    __syncthreads();
    { PH_IDS phase_prep_mod(a, lds, tid, lane, wave); }
    if (a.ph_hi == 0x7fffffff) grid.sync();
    xcd_barrier(xbar);
    layer_body(a, ws0, lds, xbar, 0);
    layer_body(a, ws0, lds, xbar, 1);
}

extern "C" void kernel_launch(void* const* d_in, const int* in_sizes, int n_in, void* d_out, int out_size, void* d_ws, size_t ws_size, hipStream_t stream) {
    static int grid_blocks = 0;
    if (!grid_blocks) {
        int dev = 0, cus = 0, per_cu = 0;
        hipGetDevice(&dev);
        hipDeviceGetAttribute(&cus, hipDeviceAttributeMultiprocessorCount, dev);
        if (hipFuncSetAttribute((const void*)mega_fwd, hipFuncAttributeMaxDynamicSharedMemorySize, LDS_BYTES) != hipSuccess) fprintf(stderr, "hipFuncSetAttribute failed\n");
        hipOccupancyMaxActiveBlocksPerMultiprocessor(&per_cu, (const void*)mega_fwd, NWAVES * 64, LDS_BYTES);
        if (per_cu < 1) per_cu = 1;
        grid_blocks = cus;
        if (ws_size < WS_END) fprintf(stderr, "kernel_launch: d_ws too small: %zu < %zu\n", ws_size, (size_t)WS_END);
    }
    Args a{};
    for (int i = 0; i < 25; ++i) a.in[i] = (const float*)d_in[i];
    a.out = (float*)d_out; a.ws = (unsigned char*)d_ws; a.ph_lo = 0; a.ph_hi = 0;
    hipMemsetAsync((unsigned char*)d_ws + WS_CTL, 0, 16384 + 1024, stream);
    void* args[] = {&a};
    hipError_t e = hipLaunchCooperativeKernel((const void*)mega_fwd, dim3(grid_blocks), dim3(NWAVES * 64), args, LDS_BYTES, stream);
    if (e != hipSuccess) fprintf(stderr, "cooperative launch failed: %s (grid %d)\n", hipGetErrorString(e), grid_blocks);
}
```

```cpp
#include <hip/hip_runtime.h>
#include <hip/hip_cooperative_groups.h>
#include <cstdio>
#include <cstdint>
namespace cg = cooperative_groups;
namespace pg8 {
#define PG8_LAS __attribute__((address_space(3)))
typedef unsigned short bf16_t;
typedef short bf16x8 __attribute__((ext_vector_type(8)));
typedef float f32x4 __attribute__((ext_vector_type(4)));
typedef unsigned u32x4 __attribute__((ext_vector_type(4)));
constexpr int BM = 256, BK = 64, HALF = 128, HTB = HALF * BK * 2  , STAGE_BYTES = 8 * HTB, NXCD = 8, WGM = 8;

__host__ __device__ __forceinline__ int lds_byte(int r, int c) { const int st = (r >> 4) * 2 + (c >> 5), rr = r & 15, cc = c & 31, ob = rr * 64 + cc * 2; return st * 1024 + (ob ^ (((ob >> 9) & 1) << 5)); }
__host__ __device__ __forceinline__ void stage_rc(int b, int& R, int& C) { const int st = b / 1024, sb = b % 1024, swz = sb ^ (((sb >> 9) & 1) << 5); R = (st >> 1) * 16 + swz / 64; C = (st & 1) * 32 + (swz % 64) / 2; }
__host__ __device__ __forceinline__ int perm32(int rho) { const int n = rho >> 4, i = rho & 15; return 8 * (i >> 2) + 4 * n + (i & 3); }

struct Unit { int pm, pn; };
struct Gemm { const bf16_t* A; const bf16_t* Bt; int M, N, K; };

struct StaticOrder {
    int nM, nN, nwg, G, c;
    __host__ __device__ void init(int M, int N, int G_, int c_) { nM = M / BM; nN = N / BM; nwg = nM * nN; G = G_; c = c_; }
    __host__ __device__ bool next(int i, Unit& u) const {
        const long L = (long)i * G + c; if (L >= nwg) return false;
        int wgid = (int)L; { const int q = nwg / NXCD, r = nwg % NXCD, xcd = wgid % NXCD, off = wgid / NXCD; wgid = (xcd < r ? xcd * (q + 1) : r * (q + 1) + (xcd - r) * q) + off; }
        const int nig = WGM * nN, gid = wgid / nig, fm = gid * WGM, gsz = (nM - fm) < WGM ? (nM - fm) : WGM;
        u.pm = fm + ((wgid % nig) % gsz); u.pn = (wgid % nig) / gsz; return true;
    }
    __device__ __forceinline__ void a_ready(const Unit&) const {}
    __device__ __forceinline__ void done(const Unit&) const {}
    __device__ __forceinline__ int kofs(const Unit&) const { return 0; }
    __device__ __forceinline__ int ntl(const Unit&, int nt) const { return nt; }
};

__device__ __forceinline__ unsigned cvt_pk_bf16(float lo, float hi) { unsigned r; asm volatile("v_cvt_pk_bf16_f32 %0, %1, %2" : "=v"(r) : "v"(lo), "v"(hi)); return r; }
typedef float f32x2 __attribute__((ext_vector_type(2)));
template <class Epi, class Sched, bool ALIGN_EPI = false, bool SP2 = false>
__device__ __forceinline__ void gemm_phase(PG8_LAS unsigned char* lds, const Gemm g, const Sched& S, const Epi& E) {
    int tid_ = threadIdx.x; asm volatile("" : "+v"(tid_));
    const int tid = tid_, wid = __builtin_amdgcn_readfirstlane(tid >> 6), lane = tid & 63, wr = wid >> 2, wc = wid & 3, fr = lane & 15, fq = lane >> 4;
    const int K = g.K, nt = K / BK;
    unsigned voffA[2], voffB[2];
#pragma unroll
    for (int i = 0; i < 2; ++i) { int R, C; stage_rc(tid * 16 + i * 8192, R, C); const int Rb = Epi::PERM ? ((R & ~31) + perm32(R & 31)) : R;
        voffA[i] = (unsigned)(R * K + C) * 2u; voffB[i] = (unsigned)(Rb * K + C) * 2u; }
    const size_t kstep = (size_t)(BK * 2);
    const size_t hstep = (size_t)HALF * K * 2;
    const size_t tstep = 2 * hstep;
    const unsigned ldsw = (unsigned)wid * 1024u;
    const int aoff = lds_byte(wr * 64 + fr, fq * 8), boff = lds_byte(wc * 32 + fr, fq * 8);
#define PG8_SA(b, h) (((b) * 2 + (h)) * HTB)
#define PG8_SB(b, h) ((4 + (b) * 2 + (h)) * HTB)
#define PG8_STAGE(bufoff, gbase, voff) do { _Pragma("unroll") for (int _i = 0; _i < 2; ++_i) \
        __builtin_amdgcn_global_load_lds((const unsigned*)((const char*)(gbase) + (voff)[_i]), (PG8_LAS unsigned*)(lds + (bufoff) + ldsw + _i * 8192), 16, 0, 0); } while (0)
#define PG8_LDA(dst, b, h) do { _Pragma("unroll") for (int m = 0; m < 4; ++m) _Pragma("unroll") for (int k = 0; k < 2; ++k) dst[m][k] = *(const PG8_LAS bf16x8*)(lds + PG8_SA(b, h) + aoff + m * 2048 + k * 1024); } while (0)
#define PG8_LDB(dst, b, h) do { _Pragma("unroll") for (int n = 0; n < 2; ++n) _Pragma("unroll") for (int k = 0; k < 2; ++k) dst[n][k] = *(const PG8_LAS bf16x8*)(lds + PG8_SB(b, h) + boff + n * 2048 + k * 1024); } while (0)
#define PG8_MMA(ai, bj, At, Bt) do { __builtin_amdgcn_s_setprio(1); _Pragma("unroll") for (int m = 0; m < 4; ++m) _Pragma("unroll") for (int n = 0; n < 2; ++n) _Pragma("unroll") for (int k = 0; k < 2; ++k) \
        acc[ai][bj][m][n] = __builtin_amdgcn_mfma_f32_16x16x32_bf16(Bt[n][k], At[m][k], acc[ai][bj][m][n], 0, 0, 0); __builtin_amdgcn_s_setprio(0); } while (0)
#define PG8_WAIT_V(n) asm volatile("s_waitcnt vmcnt(" #n ")" ::: "memory")
#define PG8_WAIT_L(n) asm volatile("s_waitcnt lgkmcnt(" #n ")" ::: "memory")
#define PG8_BAR __builtin_amdgcn_s_barrier()
#define PG8_SCHED __builtin_amdgcn_sched_barrier(0)
    Unit cur, nxt; int ui = 0;
    if (!S.next(0, cur)) return;
    f32x4 acc[2][2][4][2];
#pragma unroll
    for (int a = 0; a < 2; ++a)
#pragma unroll
        for (int b = 0; b < 2; ++b)
#pragma unroll
            for (int m = 0; m < 4; ++m)
#pragma unroll
                for (int n = 0; n < 2; ++n) acc[a][b][m][n] = (f32x4){0.f, 0.f, 0.f, 0.f};
    bf16x8 At[4][2], B0[2][2], B1[2][2];
    const char* cA = (const char*)g.A + (size_t)cur.pm * tstep + S.kofs(cur); const char* cB = (const char*)g.Bt + (size_t)cur.pn * tstep + S.kofs(cur);
    S.a_ready(cur);
    if constexpr (SP2) {
        PG8_STAGE(PG8_SB(0, 0), cB, voffB); PG8_STAGE(PG8_SB(0, 1), cB + hstep, voffB); PG8_STAGE(PG8_SA(0, 0), cA, voffA); PG8_STAGE(PG8_SA(0, 1), cA + hstep, voffA);
        if (wr == 1) PG8_BAR;
        PG8_WAIT_V(2); PG8_BAR;
        PG8_STAGE(PG8_SB(1, 0), cB + kstep, voffB); PG8_STAGE(PG8_SA(1, 0), cA + kstep, voffA); PG8_STAGE(PG8_SB(1, 1), cB + hstep + kstep, voffB);
        PG8_WAIT_V(6); PG8_BAR;
    } else {
        PG8_STAGE(PG8_SB(0, 0), cB, voffB); PG8_STAGE(PG8_SA(0, 0), cA, voffA); PG8_STAGE(PG8_SB(0, 1), cB + hstep, voffB); PG8_STAGE(PG8_SA(0, 1), cA + hstep, voffA);
        if (wr == 1) PG8_BAR;
        PG8_WAIT_V(4); PG8_BAR;
        PG8_STAGE(PG8_SB(1, 0), cB + kstep, voffB); PG8_STAGE(PG8_SA(1, 0), cA + kstep, voffA); PG8_STAGE(PG8_SB(1, 1), cB + hstep + kstep, voffB);
        PG8_WAIT_V(6); PG8_BAR;
    }
    for (;;) {
        const bool has_next = S.next(ui + 1, nxt);
        const char* nA = has_next ? (const char*)g.A + (size_t)nxt.pm * tstep + S.kofs(nxt) : cA; const char* nB = has_next ? (const char*)g.Bt + (size_t)nxt.pn * tstep + S.kofs(nxt) : cB;
        const int ntu = S.ntl(cur, nt);
        for (int t = 0; t < ntu; t += 2) {
            const bool last = (t == ntu - 2);
            const char* a1 = cA + (size_t)(t + 1) * kstep;
            const char* a2 = last ? nA : cA + (size_t)(t + 2) * kstep; const char* b2 = last ? nB : cB + (size_t)(t + 2) * kstep;
            const char* a3 = a2 + kstep; const char* b3 = b2 + kstep;
            if (last && has_next) S.a_ready(nxt);
            if constexpr (SP2) {
            PG8_LDB(B0, 0, 0); PG8_LDB(B1, 0, 1); PG8_SCHED; PG8_LDA(At, 0, 0); PG8_STAGE(PG8_SA(1, 1), a1 + hstep, voffA);
            PG8_WAIT_V(8); PG8_WAIT_L(0); PG8_BAR; PG8_MMA(0, 0, At, B0); PG8_MMA(0, 1, At, B1); PG8_BAR; PG8_SCHED;
            PG8_LDA(At, 0, 1); PG8_STAGE(PG8_SB(0, 0), b2, voffB); PG8_STAGE(PG8_SB(0, 1), b2 + hstep, voffB); PG8_STAGE(PG8_SA(0, 0), a2, voffA);
            PG8_WAIT_V(8); PG8_WAIT_L(0); PG8_BAR; PG8_MMA(1, 0, At, B0); PG8_MMA(1, 1, At, B1); PG8_BAR; PG8_SCHED;
            PG8_LDB(B0, 1, 0); PG8_LDB(B1, 1, 1); PG8_SCHED; PG8_LDA(At, 1, 0); PG8_STAGE(PG8_SA(0, 1), a2 + hstep, voffA);
            PG8_WAIT_V(8); PG8_WAIT_L(0); PG8_BAR; PG8_MMA(0, 0, At, B0); PG8_MMA(0, 1, At, B1); PG8_BAR; PG8_SCHED;
            PG8_LDA(At, 1, 1); PG8_STAGE(PG8_SB(1, 0), b3, voffB); PG8_STAGE(PG8_SB(1, 1), b3 + hstep, voffB); PG8_STAGE(PG8_SA(1, 0), a3, voffA);
            PG8_WAIT_V(8); PG8_WAIT_L(0); PG8_BAR; PG8_MMA(1, 0, At, B0); PG8_MMA(1, 1, At, B1); PG8_BAR; PG8_SCHED;
            } else {
            PG8_LDB(B0, 0, 0); PG8_SCHED; PG8_LDA(At, 0, 0); PG8_STAGE(PG8_SA(1, 1), a1 + hstep, voffA);
            PG8_WAIT_L(8); PG8_BAR; PG8_WAIT_L(0); PG8_MMA(0, 0, At, B0); PG8_BAR; PG8_SCHED;
            PG8_LDB(B1, 0, 1); PG8_STAGE(PG8_SB(0, 0), b2, voffB);
            PG8_BAR; PG8_WAIT_L(0); PG8_MMA(0, 1, At, B1); PG8_BAR;
            PG8_LDA(At, 0, 1); PG8_STAGE(PG8_SA(0, 0), a2, voffA);
            PG8_BAR; PG8_WAIT_L(0); PG8_MMA(1, 0, At, B0); PG8_BAR; PG8_SCHED;
            PG8_STAGE(PG8_SB(0, 1), b2 + hstep, voffB);
            PG8_WAIT_V(6); PG8_BAR; PG8_MMA(1, 1, At, B1); PG8_BAR;
            PG8_LDB(B0, 1, 0); PG8_SCHED; PG8_LDA(At, 1, 0); PG8_STAGE(PG8_SA(0, 1), a2 + hstep, voffA);
            PG8_WAIT_L(8); PG8_BAR; PG8_WAIT_L(0); PG8_MMA(0, 0, At, B0); PG8_BAR; PG8_SCHED;
            PG8_LDB(B1, 1, 1); PG8_STAGE(PG8_SB(1, 0), b3, voffB);
            PG8_BAR; PG8_WAIT_L(0); PG8_MMA(0, 1, At, B1); PG8_BAR;
            PG8_LDA(At, 1, 1); PG8_STAGE(PG8_SA(1, 0), a3, voffA);
            PG8_BAR; PG8_WAIT_L(0); PG8_MMA(1, 0, At, B0); PG8_BAR; PG8_SCHED;
            PG8_STAGE(PG8_SB(1, 1), b3 + hstep, voffB);
            PG8_WAIT_V(6); PG8_BAR; PG8_MMA(1, 1, At, B1); PG8_BAR;
            }
        }
        if constexpr (ALIGN_EPI) { if (wr == 0) PG8_BAR; }
        if constexpr (!Epi::AFTER_DRAIN) { E(acc, cur, wr, wc, fr, fq); S.done(cur); }
        if (!has_next) break;
#pragma unroll
        for (int a = 0; a < 2; ++a)
#pragma unroll
            for (int b = 0; b < 2; ++b)
#pragma unroll
                for (int m = 0; m < 4; ++m)
#pragma unroll
                    for (int n = 0; n < 2; ++n) acc[a][b][m][n] = (f32x4){0.f, 0.f, 0.f, 0.f};
        cur = nxt; cA = nA; cB = nB; ++ui;
        if constexpr (ALIGN_EPI) { if (wr == 1) PG8_BAR; }
    }
    PG8_WAIT_V(0);
    if constexpr (!ALIGN_EPI) { if (wr == 0) PG8_BAR; }
    PG8_BAR;
    if constexpr (Epi::AFTER_DRAIN) { E.fused(acc, cur, wr, wc, fr, fq, lds, wid, lane); S.done(cur); }
#undef PG8_SA
#undef PG8_SB
#undef PG8_STAGE
#undef PG8_LDA
#undef PG8_LDB
#undef PG8_MMA
#undef PG8_WAIT_V
#undef PG8_WAIT_L
#undef PG8_BAR
#undef PG8_SCHED
}
}

constexpr int NWAVES = 8;
constexpr int NB = 8, SEQ = 4096, T = NB * SEQ, D = 1024, DEPTH = 2;
constexpr int DINP = 2048;
constexpr int NQ = 768, NKV = 1024, DFF = 2816, NGU = 2 * DFF;
constexpr float EPS = 1e-6f;
constexpr int LDS_BYTES = 147456;
#ifndef LOOPN
#define LOOPN DEPTH
#endif

#define LAS __attribute__((address_space(3)))
typedef unsigned short bf16;
typedef float f32x4 __attribute__((ext_vector_type(4)));
typedef unsigned u32x4 __attribute__((ext_vector_type(4)));
typedef unsigned u32x2 __attribute__((ext_vector_type(2)));

constexpr size_t MiB = 1u << 20;
constexpr size_t WS_MOD = 0;
constexpr size_t WS_CTL = 480 * 1024;
constexpr size_t WS_PAR = 512 * 1024;
constexpr int P_N1W = 0, P_N2W = 1024, P_CONVW = 2048, P_CONVB = 6144, P_SSDNW = 7168, P_QNW = 7680, P_KNW = 7744, P_QPW = 7808, P_KPW = 7840, P_DTB = 7872, P_ALOG = 7880, P_DSKIP = 7888, P_STRIDE = 8192;
constexpr size_t WS_W = 1 * MiB;
constexpr size_t WO_IN = 0, WO_Q = WO_IN + (size_t)DINP * D * 2  , WO_OUT = WO_Q + (size_t)(NQ + NKV) * 512 * 2,
                 WO_GU = WO_OUT + (size_t)D * D * 2, WO_D = WO_GU + (size_t)NGU * D * 2, WL_STRIDE = WO_D + (size_t)D * DFF * 2;
static_assert(WS_W + 2 * WL_STRIDE <= 50 * MiB, "weights");
constexpr size_t WS_X1 = 50 * MiB;
constexpr size_t WS_QH = WS_X1, WS_KH = WS_QH + 48 * MiB, WS_VH = WS_KH + 48 * MiB;
constexpr size_t WS_H = 178 * MiB;
constexpr size_t WS_XBCC = WS_H;
constexpr size_t WS_R = 242 * MiB;
constexpr size_t WS_ACT = WS_R;
constexpr size_t WS_QA = WS_R  , WS_MISC = WS_QA + 32 * MiB, WS_Z = WS_MISC + 8 * MiB, WS_XBC = WS_Z + 32 * MiB,
                 WS_Y = WS_XBC, WS_QU = WS_XBC + 64 * MiB  , WS_MIX = WS_QU,
                 WS_SM = WS_QU + 112 * MiB;
constexpr size_t WS_RINV = WS_SM, WS_KPE = WS_RINV + (size_t)T * 8, WS_DT = WS_KPE + (size_t)T * 64, WS_COS = WS_DT + (size_t)T * 32, WS_SIN = WS_COS + (size_t)T * 64,
                 WS_CDEC = WS_SIN + (size_t)T * 64, WS_END = WS_CDEC + 2048 * 4;
constexpr size_t WS_ST = WS_QU + 64 * MiB;
static_assert(WS_END <= 512 * MiB, "d_ws map");

__device__ __forceinline__ float bf2f(unsigned u) { return __uint_as_float(u << 16); }
__device__ __forceinline__ unsigned f2bf(float f) { unsigned u = __float_as_uint(f); return (u + 0x7fffu + ((u >> 16) & 1u)) >> 16; }
typedef __bf16 hwbf16x2 __attribute__((ext_vector_type(2)));
typedef float f32x2 __attribute__((ext_vector_type(2)));
__device__ __forceinline__ unsigned pk2(float lo, float hi) { const f32x2 v = {lo, hi}; return __builtin_bit_cast(unsigned, __builtin_convertvector(v, hwbf16x2)); }
__device__ __forceinline__ float lo16(unsigned w) { return __uint_as_float(w << 16); }
__device__ __forceinline__ float hi16(unsigned w) { return __uint_as_float(w & 0xffff0000u); }
__device__ __forceinline__ float silu_f(float v) { return v * __builtin_amdgcn_rcpf(1.f + __expf(-v)); }
__device__ __forceinline__ float wave_sum(float v) {
#pragma unroll
    for (int o = 1; o < 64; o <<= 1) v += __shfl_xor(v, o);
    return v;
}
#define LDS_WAIT() asm volatile("s_waitcnt lgkmcnt(0)" ::: "memory")
#define GAS __attribute__((address_space(1)))
#define TP_WRITE(d32, RW, va, vb) do { \
    (d32)[0 * (RW)] = ((va).x & 0xffffu) | ((vb).x << 16); (d32)[1 * (RW)] = ((va).x >> 16) | ((vb).x & 0xffff0000u); \
    (d32)[2 * (RW)] = ((va).y & 0xffffu) | ((vb).y << 16); (d32)[3 * (RW)] = ((va).y >> 16) | ((vb).y & 0xffff0000u); \
    (d32)[4 * (RW)] = ((va).z & 0xffffu) | ((vb).z << 16); (d32)[5 * (RW)] = ((va).z >> 16) | ((vb).z & 0xffff0000u); \
    (d32)[6 * (RW)] = ((va).w & 0xffffu) | ((vb).w << 16); (d32)[7 * (RW)] = ((va).w >> 16) | ((vb).w & 0xffff0000u); } while (0)
template <class T> __device__ __forceinline__ GAS T* as_global(T* p) { return (GAS T*)p; }

struct Args { const float* in[25]; float* out; unsigned char* ws; int ph_lo, ph_hi; };
static_assert(sizeof(Args) == 25 * 8 + 8 + 8 + 8, "Args has no padding");

enum { I_X = 0, I_C, I_POS, I_N1W, I_N2W, I_WADA, I_BADA, I_WIN, I_QANW, I_WQUP, I_KVANW, I_WKVUP, I_QNW, I_QPW, I_KNW, I_KPW, I_CONVW, I_CONVB, I_DTB, I_ALOG, I_DSKIP,
       I_SSDNW, I_WOUT, I_WGU, I_WDOWN };

__device__ __forceinline__ int src_col(int mat, int n) {
    switch (mat) {
    case 0:
        if (n < 416) return n;
        if (n < 424) return 1952 + (n - 416);
        if (n < 512) return -1;
        if (n < 1024) return 416 + (n - 512);
        return 928 + (n - 1024);
    case 1: {
        if (n < 512) { const int pn = n >> 8, bj = (n >> 7) & 1, wc = (n >> 5) & 3, j = n & 31; return (4 * pn + wc) * 96 + 32 * bj + j; }
        const int r = n - 512, bj = r >> 7, wc = (r >> 5) & 3, jc = r & 31;
        return (4 * bj + wc) * 96 + 64 + 16 * ((jc >> 2) & 1) + 4 * (jc >> 3) + (jc & 3); }
    case 2: {
        if (n < 512) { const int pn = n >> 8, bj = (n >> 7) & 1, wc = (n >> 5) & 3, j = n & 31; return (4 * pn + wc) * 128 + 32 * bj + j; }
        const int r = n - 512; return (r >> 6) * 128 + 64 + (r & 63); }
    case 3: return n;
    case 4: { const int pn = n >> 8, bj = (n >> 7) & 1, j = n & 127; return (bj ? DFF : 0) + 128 * pn + j; }
    default: return n;
    }
}
__device__ __forceinline__ void transpose_item(const GAS float* __restrict__ W, int Ksrc, int Nsrc, GAS bf16* WT, int Kdst, const GAS float* kscale, int mat, LAS float* scr, int kb, int nb, int lane, int koff = 0, int noff = 0) {
    const int k0 = 64 * kb, n0 = 32 * nb;
    const int ns = src_col(mat, n0 - noff + (lane & 31));
#pragma unroll
    for (int i = 0; i < 32; ++i) {
        const int kk = 2 * i + (lane >> 5), k = k0 + kk - koff;
        float v = 0.f;
        if (ns >= 0 && k >= 0 && k < Ksrc) { v = W[(size_t)k * Nsrc + ns]; if (kscale) v *= kscale[k]; }
        scr[kk * 33 + (lane & 31)] = v;
    }
    LDS_WAIT();
    const int c = lane & 7;
#pragma unroll
    for (int j = 0; j < 4; ++j) {
        const int n = (lane >> 3) + 8 * j; const LAS float* s = scr + (8 * c) * 33 + n;
        u32x4 o; o.x = pk2(s[0 * 33], s[1 * 33]); o.y = pk2(s[2 * 33], s[3 * 33]); o.z = pk2(s[4 * 33], s[5 * 33]); o.w = pk2(s[6 * 33], s[7 * 33]);
        *(GAS u32x4*)(WT + (size_t)(n0 + n) * Kdst + k0 + 8 * c) = o;
    }
    LDS_WAIT();
}

__device__ __forceinline__ void phase_prep(const Args& a, LAS unsigned char* lds, int tid, int lane, int wave) {
    GAS unsigned char* ws = as_global(a.ws);
    const int gw = blockIdx.x * NWAVES + wave, NGW = gridDim.x * NWAVES;
    LAS float* scr = (LAS float*)(lds + wave * 16384);
    constexpr int IT0 = 16 * 64, IT1 = 8 * 24, IT2 = 8 * 32, IT3 = 16 * 32, IT4 = 16 * 176, IT5 = 44 * 32, ITL = IT0 + IT1 + IT2 + IT3 + IT4 + IT5;
    for (int it = gw; it < 2 * ITL; it += NGW) {
        const int l = it / ITL; int r = it % ITL;
        GAS bf16* wl = (GAS bf16*)(ws + WS_W + (size_t)l * WL_STRIDE);
        if (r < IT0) { transpose_item(as_global(a.in[I_WIN]) + (size_t)l * D * 1960, D, 1960, (GAS bf16*)((GAS unsigned char*)wl + WO_IN), D, nullptr, 0, scr, r / 64, r % 64, lane); continue; } r -= IT0;
        if (r < IT1) { transpose_item(as_global(a.in[I_WQUP]) + (size_t)l * 256 * NQ, 256, NQ, (GAS bf16*)((GAS unsigned char*)wl + WO_Q), 512, as_global(a.in[I_QANW]) + l * 256, 1, scr, r / 24, r % 24, lane, 0, 0); continue; } r -= IT1;
        if (r < IT2) { transpose_item(as_global(a.in[I_WKVUP]) + (size_t)l * 128 * NKV, 128, NKV, (GAS bf16*)((GAS unsigned char*)wl + WO_Q), 512, as_global(a.in[I_KVANW]) + l * 128, 2, scr, r / 32, 24 + r % 32, lane, 256, 768); continue; } r -= IT2;
        if (r < IT3) { transpose_item(as_global(a.in[I_WOUT]) + (size_t)l * D * D, D, D, (GAS bf16*)((GAS unsigned char*)wl + WO_OUT), D, nullptr, 3, scr, r / 32, r % 32, lane); continue; } r -= IT3;
        if (r < IT4) { transpose_item(as_global(a.in[I_WGU]) + (size_t)l * D * NGU, D, NGU, (GAS bf16*)((GAS unsigned char*)wl + WO_GU), D, nullptr, 4, scr, r / 176, r % 176, lane); continue; } r -= IT4;
        transpose_item(as_global(a.in[I_WDOWN]) + (size_t)l * DFF * D, DFF, D, (GAS bf16*)((GAS unsigned char*)wl + WO_D), DFF, nullptr, 5, scr, r / 32, r % 32, lane);
    }
    {
        GAS float* PAR = (GAS float*)(ws + WS_PAR);
        for (int i = blockIdx.x * 512 + tid; i < 2 * P_STRIDE; i += gridDim.x * 512) {
            const int l = i / P_STRIDE, r = i % P_STRIDE; float v = 0.f;
            if (r < P_N2W) v = as_global(a.in[I_N1W])[l * 1024 + r];
            else if (r < P_CONVW) v = as_global(a.in[I_N2W])[l * 1024 + r - P_N2W];
            else if (r < P_CONVB) v = as_global(a.in[I_CONVW])[l * 4096 + r - P_CONVW];
            else if (r < P_SSDNW) v = as_global(a.in[I_CONVB])[l * 1024 + r - P_CONVB];
            else if (r < P_QNW) v = as_global(a.in[I_SSDNW])[l * 512 + r - P_SSDNW];
            else if (r < P_KNW) v = as_global(a.in[I_QNW])[l * 64 + r - P_QNW];
            else if (r < P_QPW) v = as_global(a.in[I_KNW])[l * 64 + r - P_KNW];
            else if (r < P_KPW) v = as_global(a.in[I_QPW])[l * 32 + r - P_QPW];
            else if (r < P_DTB) v = as_global(a.in[I_KPW])[l * 32 + r - P_KPW];
            else if (r < P_ALOG) v = as_global(a.in[I_DTB])[l * 8 + r - P_DTB];
            else if (r < P_DSKIP) v = as_global(a.in[I_ALOG])[l * 8 + r - P_ALOG];
            else if (r < P_DSKIP + 8) v = as_global(a.in[I_DSKIP])[l * 8 + r - P_DSKIP];
            PAR[i] = v;
        }
    }
    {
        GAS float* COS = (GAS float*)(ws + WS_COS); GAS float* SIN = (GAS float*)(ws + WS_SIN); const GAS int* pos = (const GAS int*)as_global(a.in[I_POS]);
        for (int i = blockIdx.x * 512 + tid; i < T * 16; i += gridDim.x * 512) {
            const int t = i >> 4, j = i & 15;
            const float invf = 1.0f / powf(10000.0f, (float)(2 * j) / 32.0f);
            const float ang = (float)pos[t] * invf;
            const double rev = (double)ang * 0.15915494309189533577;
            const float fr = (float)(rev - rint(rev));
            SIN[i] = __builtin_amdgcn_sinf(fr); COS[i] = __builtin_amdgcn_cosf(fr);
        }
    }
}
__device__ __forceinline__ void phase_prep_mod(const Args& a, LAS unsigned char* lds, int tid, int lane, int wave) {
    GAS unsigned char* ws = as_global(a.ws);
    {
        GAS float* MOD = (GAS float*)(ws + WS_MOD);
        LAS float* red = (LAS float*)lds;
        LAS float* cact = (LAS float*)(lds + 16384);
        for (int i = tid; i < 8 * D; i += 512) cact[i] = silu_f(as_global(a.in[I_C])[i]);
        __syncthreads();
        for (int it = blockIdx.x; it < 2 * 96; it += gridDim.x) {
            const int l = it / 96, cg = it % 96;
            const GAS float* wa = as_global(a.in[I_WADA]) + (size_t)l * D * 6144 + 64 * cg + lane;
            float acc[8];
#pragma unroll
            for (int b = 0; b < 8; ++b) acc[b] = 0.f;
#pragma nounroll
            for (int kk0 = 0; kk0 < 128; kk0 += 16) {
                float w[16];
#pragma unroll
                for (int j = 0; j < 16; ++j) w[j] = wa[(size_t)(wave * 128 + kk0 + j) * 6144];
#pragma unroll
                for (int j4 = 0; j4 < 4; ++j4) {
#pragma unroll
                    for (int b = 0; b < 8; ++b) {
                        const f32x4 cv = *(const LAS f32x4*)(cact + b * D + wave * 128 + kk0 + 4 * j4);
                        acc[b] += cv[0] * w[4 * j4] + cv[1] * w[4 * j4 + 1] + cv[2] * w[4 * j4 + 2] + cv[3] * w[4 * j4 + 3];
                    }
                }
            }
#pragma unroll
            for (int b = 0; b < 8; ++b) red[(wave * 8 + b) * 64 + lane] = acc[b];
            __syncthreads();
            {
                float s = as_global(a.in[I_BADA])[l * 6144 + 64 * cg + lane];
#pragma unroll
                for (int w2 = 0; w2 < 8; ++w2) s += red[(w2 * 8 + wave) * 64 + lane];
                MOD[(size_t)(l * 8 + wave) * 6144 + 64 * cg + lane] = s;
            }
            __syncthreads();
        }
    }
}

template <bool IN_BF16>
__device__ __forceinline__ void phase_norm(const GAS void* __restrict__ x, const GAS float* __restrict__ nw, const GAS float* __restrict__ modl  , int sh_off, int sc_off, GAS bf16* H, int lane, int wave) {
    const int gw = blockIdx.x * NWAVES + wave, NGW = gridDim.x * NWAVES;
    for (int m = gw; m < T; m += NGW) {
        f32x4 v[4]; float s = 0.f;
#pragma unroll
        for (int j = 0; j < 4; ++j) {
            if (IN_BF16) { const u32x2 p = *((const GAS u32x2*)((const GAS bf16*)x + (size_t)m * D) + lane + 64 * j); v[j] = (f32x4){lo16(p.x), hi16(p.x), lo16(p.y), hi16(p.y)}; }
            else v[j] = *((const GAS f32x4*)((const GAS float*)x + (size_t)m * D) + lane + 64 * j);
            s += (v[j].x * v[j].x + v[j].y * v[j].y) + (v[j].z * v[j].z + v[j].w * v[j].w);
        }
        const float rinv = rsqrtf(wave_sum(s) * (1.f / D) + EPS);
        const GAS float* mb = modl + (size_t)(m >> 12) * 6144;
        GAS u32x2* o = (GAS u32x2*)(H + (size_t)m * D) + lane;
#pragma unroll
        for (int j = 0; j < 4; ++j) {
            const int c = 4 * lane + 256 * j;
            const f32x4 w = *(const GAS f32x4*)(nw + c), sc = *(const GAS f32x4*)(mb + sc_off + c), sh = *(const GAS f32x4*)(mb + sh_off + c);
            const f32x4 h = v[j] * rinv * w * (sc + 1.0f) + sh;
            u32x2 p; p.x = pk2(h.x, h.y); p.y = pk2(h.z, h.w); o[64 * j] = p;
        }
    }
}

using pg8::Unit; using pg8::cvt_pk_bf16;
#define EPI_PACK8(W_, v0, v1) do { (W_).x = cvt_pk_bf16(v0[0], v0[1]); (W_).y = cvt_pk_bf16(v0[2], v0[3]); (W_).z = cvt_pk_bf16(v1[0], v1[1]); (W_).w = cvt_pk_bf16(v1[2], v1[3]); } while (0)
struct EpiIn {
    static constexpr bool PERM = true, AFTER_DRAIN = false;
    GAS bf16*QA, *Z, *XBC; GAS float* MISC;
    __device__ __forceinline__ void operator()(const f32x4 (&acc)[2][2][4][2], const Unit& u, int wr, int wc, int fr, int fq) const {
        asm volatile("" : "+v"(fr), "+v"(fq));
        const int row0 = u.pm * 256 + wr * 64 + fr, cb = wc * 32 + 8 * fq, pn = u.pn;
        GAS bf16* base; int ldc;
        if (pn < 2) { base = QA + pn * 256; ldc = 512; } else if (pn < 4) { base = Z + (pn - 2) * 256; ldc = 512; } else { base = XBC + (pn - 4) * 256; ldc = 1024; }
#pragma unroll
        for (int ai = 0; ai < 2; ++ai)
#pragma unroll
            for (int m = 0; m < 4; ++m) {
                const int row = row0 + ai * 128 + m * 16;
#pragma unroll
                for (int bj = 0; bj < 2; ++bj) {
                    const f32x4 v0 = acc[ai][bj][m][0], v1 = acc[ai][bj][m][1];
                    u32x4 w; EPI_PACK8(w, v0, v1);
                    *(GAS u32x4*)(base + (size_t)row * ldc + bj * 128 + cb) = w;
                    if (pn == 1 && bj == 1 && wc < 2) { GAS float* mp = MISC + (size_t)row * 64 + cb; *(GAS f32x4*)mp = v0; *(GAS f32x4*)(mp + 4) = v1; }
                }
            }
    }
};
template <bool IN_BF16, bool OUT_BF16> struct EpiResT {
    static constexpr bool PERM = false, AFTER_DRAIN = false;
    const GAS void* xin; GAS void* out; const GAS float* gate;
    __device__ __forceinline__ void operator()(const f32x4 (&acc)[2][2][4][2], const Unit& u, int wr, int wc, int fr, int fq) const {
        asm volatile("" : "+v"(fr), "+v"(fq));
        const int row0 = u.pm * 256 + wr * 64 + fr, c0 = u.pn * 256 + wc * 32 + 4 * fq;
        const GAS float* gb = gate + (size_t)((u.pm * 256) >> 12) * 6144;
        f32x4 g[2][2];
#pragma unroll
        for (int bj = 0; bj < 2; ++bj)
#pragma unroll
            for (int n = 0; n < 2; ++n) g[bj][n] = *(const GAS f32x4*)(gb + c0 + bj * 128 + n * 16);
#pragma unroll
        for (int ai = 0; ai < 2; ++ai)
#pragma unroll
            for (int mp = 0; mp < 2; ++mp) {
                f32x4 xi[2][2][2];
#pragma unroll
                for (int mm = 0; mm < 2; ++mm)
#pragma unroll
                    for (int bj = 0; bj < 2; ++bj)
#pragma unroll
                        for (int n = 0; n < 2; ++n) {
                            const size_t o2 = (size_t)(row0 + ai * 128 + (2 * mp + mm) * 16) * D + c0 + bj * 128 + n * 16;
                            if (IN_BF16) { const u32x2 pq = *(const GAS u32x2*)((const GAS bf16*)xin + o2); xi[mm][bj][n] = (f32x4){lo16(pq.x), hi16(pq.x), lo16(pq.y), hi16(pq.y)}; }
                            else xi[mm][bj][n] = *(const GAS f32x4*)((const GAS float*)xin + o2);
                        }
#pragma unroll
                for (int mm = 0; mm < 2; ++mm)
#pragma unroll
                    for (int bj = 0; bj < 2; ++bj)
#pragma unroll
                        for (int n = 0; n < 2; ++n) {
                            const int m = 2 * mp + mm;
                            const size_t o2 = (size_t)(row0 + ai * 128 + m * 16) * D + c0 + bj * 128 + n * 16;
                            const f32x4 o = xi[mm][bj][n] + g[bj][n] * acc[ai][bj][m][n];
                            if (OUT_BF16) { u32x2 pq; pq.x = cvt_pk_bf16(o[0], o[1]); pq.y = cvt_pk_bf16(o[2], o[3]); *(GAS u32x2*)((GAS bf16*)out + o2) = pq; }
                            else *(GAS f32x4*)((GAS float*)out + o2) = o;
                        }
            }
    }
};
struct EpiSwiglu {
    static constexpr bool PERM = true, AFTER_DRAIN = false;
    GAS bf16* O;
    __device__ __forceinline__ void operator()(const f32x4 (&acc)[2][2][4][2], const Unit& u, int wr, int wc, int fr, int fq) const {
        asm volatile("" : "+v"(fr), "+v"(fq));
        const int row0 = u.pm * 256 + wr * 64 + fr, cb = u.pn * 128 + wc * 32 + 8 * fq;
#pragma unroll
        for (int ai = 0; ai < 2; ++ai)
#pragma unroll
            for (int m = 0; m < 4; ++m) {
                const int row = row0 + ai * 128 + m * 16;
                f32x4 v0, v1;
#pragma unroll
                for (int e = 0; e < 4; ++e) { v0[e] = silu_f(acc[ai][0][m][0][e]) * acc[ai][1][m][0][e]; v1[e] = silu_f(acc[ai][0][m][1][e]) * acc[ai][1][m][1][e]; }
                u32x4 w; EPI_PACK8(w, v0, v1); *(GAS u32x4*)(O + (size_t)row * DFF + cb) = w;
            }
    }
};

constexpr float QSCL = 0.10206207261596575f * 1.4426950408889634f;
struct EpiQkv {
    static constexpr bool PERM = true, AFTER_DRAIN = false;
    const GAS float*RINV, *COS, *SIN, *par; GAS bf16*QH, *KH, *VH;
    __device__ __forceinline__ void operator()(const f32x4 (&acc)[2][2][4][2], const Unit& u, int wr, int wc, int fr, int fq) const {
        asm volatile("" : "+v"(fr), "+v"(fq));
        const int row0 = u.pm * 256 + wr * 64 + fr, b8 = ((u.pm * 256) >> 12) * 8, pn = u.pn;
        if (pn >= 5) {
            const int hd = 4 * (pn - 5) + (wc >> 1);
#pragma unroll
            for (int ai = 0; ai < 2; ++ai)
#pragma unroll
                for (int m = 0; m < 4; ++m) {
                    const int row = row0 + ai * 128 + m * 16, sq = row & (SEQ - 1);
                    const float rkv = RINV[2 * row + 1];
#pragma unroll
                    for (int bj = 0; bj < 2; ++bj) {
                        const f32x4 v0 = acc[ai][bj][m][0] * rkv, v1 = acc[ai][bj][m][1] * rkv; u32x4 w; EPI_PACK8(w, v0, v1);
                        *(GAS u32x4*)(VH + ((size_t)(b8 + hd + 2 * bj) * SEQ + sq) * 64 + 32 * (wc & 1) + 8 * fq) = w;
                    }
                }
        } else if (pn == 2) {
            const f32x4 w0 = *(const GAS f32x4*)(par + P_QPW + 4 * fq), w1 = *(const GAS f32x4*)(par + P_QPW + 16 + 4 * fq);
#pragma unroll
            for (int ai = 0; ai < 2; ++ai)
#pragma unroll
                for (int m = 0; m < 4; ++m) {
                    const int row = row0 + ai * 128 + m * 16, sq = row & (SEQ - 1);
                    const float rq = RINV[2 * row];
                    const f32x4 cs = *(const GAS f32x4*)(COS + (size_t)row * 16 + 4 * fq), sn = *(const GAS f32x4*)(SIN + (size_t)row * 16 + 4 * fq);
#pragma unroll
                    for (int bj = 0; bj < 2; ++bj) {
                        f32x4 v0 = acc[ai][bj][m][0] * rq, v1 = acc[ai][bj][m][1] * rq;
                        float ss = (v0[0] * v0[0] + v0[1] * v0[1]) + (v0[2] * v0[2] + v0[3] * v0[3]) + (v1[0] * v1[0] + v1[1] * v1[1]) + (v1[2] * v1[2] + v1[3] * v1[3]);
                        ss += __shfl_xor(ss, 16); ss += __shfl_xor(ss, 32);
                        const float rn = rsqrtf(ss * (1.f / 32.f) + EPS) * QSCL;
                        v0 = v0 * rn * w0; v1 = v1 * rn * w1;
                        const f32x4 o0 = v0 * cs - v1 * sn, o1 = v1 * cs + v0 * sn;
                        u32x2 p0, p1; p0.x = cvt_pk_bf16(o0[0], o0[1]); p0.y = cvt_pk_bf16(o0[2], o0[3]); p1.x = cvt_pk_bf16(o1[0], o1[1]); p1.y = cvt_pk_bf16(o1[2], o1[3]);
                        GAS bf16* qp = QH + ((size_t)(b8 + 4 * bj + wc) * SEQ + sq) * 96 + 64 + 4 * fq;
                        *(GAS u32x2*)qp = p0; *(GAS u32x2*)(qp + 16) = p1;
                    }
                }
        } else {
            const bool isq = pn < 2; const int pnl = isq ? pn : pn - 3, hd = 4 * pnl + wc, ro = isq ? 0 : 1;
            const GAS float* wv = par + (isq ? P_QNW : P_KNW) + 8 * fq; const float scl = isq ? QSCL : 1.f;
            GAS bf16* O = isq ? QH : KH;
            f32x4 w[2][2];
#pragma unroll
            for (int bj = 0; bj < 2; ++bj)
#pragma unroll
                for (int n = 0; n < 2; ++n) w[bj][n] = *(const GAS f32x4*)(wv + 32 * bj + 4 * n);
#pragma unroll
            for (int ai = 0; ai < 2; ++ai)
#pragma unroll
                for (int m = 0; m < 4; ++m) {
                    const int row = row0 + ai * 128 + m * 16, sq = row & (SEQ - 1);
                    const float rr = RINV[2 * row + ro];
                    f32x4 v[2][2]; float ss = 0.f;
#pragma unroll
                    for (int bj = 0; bj < 2; ++bj)
#pragma unroll
                        for (int n = 0; n < 2; ++n) { v[bj][n] = acc[ai][bj][m][n] * rr; ss += (v[bj][n][0] * v[bj][n][0] + v[bj][n][1] * v[bj][n][1]) + (v[bj][n][2] * v[bj][n][2] + v[bj][n][3] * v[bj][n][3]); }
                    ss += __shfl_xor(ss, 16); ss += __shfl_xor(ss, 32);
                    const float rn = rsqrtf(ss * (1.f / 64.f) + EPS) * scl;
#pragma unroll
                    for (int bj = 0; bj < 2; ++bj) {
                        const f32x4 o0 = v[bj][0] * rn * w[bj][0], o1 = v[bj][1] * rn * w[bj][1]; u32x4 pw; EPI_PACK8(pw, o0, o1);
                        *(GAS u32x4*)(O + ((size_t)(b8 + hd) * SEQ + sq) * 96 + 32 * bj + 8 * fq) = pw;
                    }
                }
        }
    }
};

struct QkvOrder {
    pg8::StaticOrder S;
    __device__ __forceinline__ bool next(int i, Unit& u) const { return S.next(i, u); }
    __device__ __forceinline__ void a_ready(const Unit&) const {}
    __device__ __forceinline__ void done(const Unit&) const {}
    __device__ __forceinline__ int kofs(const Unit& u) const { return u.pn < 3 ? 0 : 512; }
    __device__ __forceinline__ int ntl(const Unit&, int) const { return 4; }
};
template <class Epi>
__device__ __forceinline__ void run_gemm(LAS unsigned char* lds, const GAS bf16* A, const GAS bf16* Bt, int N, int K, const Epi& E) {
    pg8::Gemm g{(const bf16*)A, (const bf16*)Bt, T, N, K}; pg8::StaticOrder S; S.init(T, N, (int)gridDim.x, (int)blockIdx.x);
    pg8::gemm_phase<Epi, pg8::StaticOrder, true, true>(lds, g, S, E);
}

__device__ __forceinline__ void phase_c(GAS unsigned char* ws, const GAS float* par, int tid, int lane, int wave) {
    const GAS bf16* QA = (const GAS bf16*)(ws + WS_QA); const GAS float* MISC = (const GAS float*)(ws + WS_MISC);
    GAS float* RINV = (GAS float*)(ws + WS_RINV); GAS bf16* KH = (GAS bf16*)(ws + WS_KH); GAS float* DT = (GAS float*)(ws + WS_DT);
    const GAS float* COS = (const GAS float*)(ws + WS_COS); const GAS float* SIN = (const GAS float*)(ws + WS_SIN);
    const int gw = blockIdx.x * NWAVES + wave, NGW = gridDim.x * NWAVES;
    const float kpw = par[P_KPW + (lane & 31)];
    const float dtb = par[P_DTB + (lane & 7)];
    for (int m0 = gw * 4; m0 < T; m0 += NGW * 4) {
        u32x2 q[4]; unsigned kv[4]; float mv[4], cs[4], sn[4];
#pragma unroll
        for (int j = 0; j < 4; ++j) {
            const int m = m0 + j;
            q[j] = *((const GAS u32x2*)(QA + (size_t)m * 512) + lane);
            kv[j] = *((const GAS unsigned*)(QA + (size_t)m * 512 + 256) + lane);
            mv[j] = MISC[(size_t)m * 64 + lane];
            cs[j] = COS[(size_t)m * 16 + (lane & 15)]; sn[j] = SIN[(size_t)m * 16 + (lane & 15)];
        }
        float sq[4], sk[4], sp[4];
#pragma unroll
        for (int j = 0; j < 4; ++j) {
            sq[j] = lo16(q[j].x) * lo16(q[j].x) + hi16(q[j].x) * hi16(q[j].x) + lo16(q[j].y) * lo16(q[j].y) + hi16(q[j].y) * hi16(q[j].y);
            sk[j] = lo16(kv[j]) * lo16(kv[j]) + hi16(kv[j]) * hi16(kv[j]);
            sp[j] = lane < 32 ? mv[j] * mv[j] : 0.f;
        }
#pragma unroll
        for (int o = 1; o < 64; o <<= 1)
#pragma unroll
            for (int j = 0; j < 4; ++j) { sq[j] += __shfl_xor(sq[j], o); sk[j] += __shfl_xor(sk[j], o); sp[j] += __shfl_xor(sp[j], o); }
#pragma unroll
        for (int j = 0; j < 4; ++j) {
            const int m = m0 + j;
            if (lane == 0) { RINV[2 * m] = rsqrtf(sq[j] * (1.f / 256.f) + EPS); RINV[2 * m + 1] = rsqrtf(sk[j] * (1.f / 128.f) + EPS); }
            const float vn = mv[j] * rsqrtf(sp[j] * (1.f / 32.f) + EPS) * kpw;
            const float partner = __shfl_xor(vn, 16);
            const float ro = (lane & 16) ? vn * cs[j] + partner * sn[j] : vn * cs[j] - partner * sn[j];
            { const bf16 rb = (bf16)f2bf(__shfl(ro, lane & 31));
              GAS bf16* kp = KH + ((size_t)((m >> 12) * 8 + (lane >> 5)) * SEQ + (m & (SEQ - 1))) * 96 + 64 + (lane & 31);
#pragma unroll
              for (int i = 0; i < 4; ++i) kp[(size_t)(2 * i) * SEQ * 96] = rb; }
            if (lane >= 32 && lane < 40) { const float v = mv[j] + dtb; DT[(size_t)m * 8 + (lane - 32)] = fmaxf(v, 0.f) + log1pf(__expf(-fabsf(v))); }
        }
    }
    const GAS bf16* XBC = (const GAS bf16*)(ws + WS_XBC); GAS bf16* XBCC = (GAS bf16*)(ws + WS_XBCC);
    for (int item = blockIdx.x * 512 + tid; item < 128 * (T / 32); item += gridDim.x * 512) {
        const int ch0 = (item & 127) * 8, t0 = (item >> 7) * 32;
        f32x4 w[4][2], bs[2];
#pragma unroll
        for (int k = 0; k < 4; ++k) { w[k][0] = *(const GAS f32x4*)(par + P_CONVW + k * 1024 + ch0); w[k][1] = *(const GAS f32x4*)(par + P_CONVW + k * 1024 + ch0 + 4); }
        bs[0] = *(const GAS f32x4*)(par + P_CONVB + ch0); bs[1] = *(const GAS f32x4*)(par + P_CONVB + ch0 + 4);
        const GAS bf16* src = XBC + (size_t)t0 * 1024 + ch0; GAS bf16* dst = XBCC + (size_t)t0 * 1024 + ch0;
        u32x4 r0 = (u32x4){0u, 0u, 0u, 0u}, r1 = r0, r2 = r0;
        if ((t0 & (SEQ - 1)) != 0) { r0 = *(const GAS u32x4*)(src - 3 * 1024); r1 = *(const GAS u32x4*)(src - 2 * 1024); r2 = *(const GAS u32x4*)(src - 1024); }
#pragma unroll 4
        for (int tt = 0; tt < 32; ++tt) {
            const u32x4 r3 = *(const GAS u32x4*)(src + (size_t)tt * 1024);
            f32x4 a0 = bs[0], a1 = bs[1];
#define CV_TAP(W, R) do { a0[0] += (W)[0][0] * lo16((R).x); a0[1] += (W)[0][1] * hi16((R).x); a0[2] += (W)[0][2] * lo16((R).y); a0[3] += (W)[0][3] * hi16((R).y); \
                          a1[0] += (W)[1][0] * lo16((R).z); a1[1] += (W)[1][1] * hi16((R).z); a1[2] += (W)[1][2] * lo16((R).w); a1[3] += (W)[1][3] * hi16((R).w); } while (0)
            CV_TAP(w[0], r0); CV_TAP(w[1], r1); CV_TAP(w[2], r2); CV_TAP(w[3], r3);
#undef CV_TAP
            u32x4 o; o.x = pk2(silu_f(a0[0]), silu_f(a0[1])); o.y = pk2(silu_f(a0[2]), silu_f(a0[3])); o.z = pk2(silu_f(a1[0]), silu_f(a1[1])); o.w = pk2(silu_f(a1[2]), silu_f(a1[3]));
            *(GAS u32x4*)(dst + (size_t)tt * 1024) = o;
            r0 = r1; r1 = r2; r2 = r3;
        }
    }
}

typedef float f32x16 __attribute__((ext_vector_type(16)));
typedef short s16x8 __attribute__((ext_vector_type(8)));
#define MFMA32(a, b, c) __builtin_amdgcn_mfma_f32_32x32x16_bf16((a), (b), (c), 0, 0, 0)
constexpr int AT_KROW = 208, AT_VROW = 136, AT_KBUF = 64 * AT_KROW, AT_VBUF = 64 * AT_VROW, AT_BUF = AT_KBUF + AT_VBUF;
__device__ __forceinline__ int crow16(int i, int h) { return (i & 3) + 8 * (i >> 2) + 4 * h; }

__device__ __forceinline__ void attn_unit(const GAS bf16* __restrict__ QH, const GAS bf16* __restrict__ KH, const GAS bf16* __restrict__ VH, GAS bf16* __restrict__ MIX, LAS unsigned char* lds,
                                          int bh, int qb, int tid, int lane, int wave) {
    const int r = lane & 31, h = lane >> 5;
    const int qw = qb * 256 + 32 * wave;
    s16x8 qf[6];
    { const GAS bf16* qrow = QH + ((size_t)bh * SEQ + qw + r) * 96 + 8 * h;
#pragma unroll
      for (int s = 0; s < 6; ++s) qf[s] = *(const GAS s16x8*)(qrow + 16 * s); }
    f32x16 o0, o1;
#pragma unroll
    for (int i = 0; i < 16; ++i) { o0[i] = 0.f; o1[i] = 0.f; }
    float mrun = 0.f, lsum = 0.f;
    const int ntiles = (qb + 1) * 4;
    const GAS unsigned char* kbase = (const GAS unsigned char*)(KH + (size_t)bh * SEQ * 96);
    const GAS unsigned char* vbase = (const GAS unsigned char*)(VH + (size_t)bh * SEQ * 64);
    const int ck1 = tid + 256;
    const int kd0 = (tid / 12) * AT_KROW + (tid % 12) * 16, kd1 = (ck1 / 12) * AT_KROW + (ck1 % 12) * 16;
    const int vkp = tid & 31, vc = (tid >> 5) & 7;
    u32x4 kr0, kr1, vr;
    kr0 = *(const GAS u32x4*)(kbase + (size_t)tid * 16);
    if (tid < 256) { kr1 = *(const GAS u32x4*)(vbase + (size_t)(2 * vkp * 8 + vc) * 16); vr = *(const GAS u32x4*)(vbase + (size_t)((2 * vkp + 1) * 8 + vc) * 16); }
    else { kr1 = *(const GAS u32x4*)(kbase + (size_t)ck1 * 16); vr = kr1; }
#define AT_STORE(bufp) do { LAS unsigned char* kb_ = (bufp); LAS unsigned char* vb_ = kb_ + AT_KBUF; \
        *(LAS u32x4*)(kb_ + kd0) = kr0; \
        if (tid < 256) { LAS unsigned* vt_ = (LAS unsigned*)(vb_ + (8 * vc) * AT_VROW + vkp * 4); TP_WRITE(vt_, AT_VROW / 4, kr1, vr); } \
        else *(LAS u32x4*)(kb_ + kd1) = kr1; } while (0)
    AT_STORE(lds);
    for (int jt = 0; jt < ntiles; ++jt) {
        __syncthreads();
        const int k0 = jt * 64;
        const bool more = jt + 1 < ntiles;
        if (more) {
            const GAS unsigned char* kt = kbase + (size_t)(k0 + 64) * 192; const GAS unsigned char* vt = vbase + (size_t)(k0 + 64) * 128;
            kr0 = *(const GAS u32x4*)(kt + (size_t)tid * 16);
            if (tid < 256) { kr1 = *(const GAS u32x4*)(vt + (size_t)(2 * vkp * 8 + vc) * 16); vr = *(const GAS u32x4*)(vt + (size_t)((2 * vkp + 1) * 8 + vc) * 16); }
            else kr1 = *(const GAS u32x4*)(kt + (size_t)ck1 * 16);
        }
        LAS unsigned char* kb = lds + (jt & 1) * AT_BUF; LAS unsigned char* vb = kb + AT_KBUF;
        if (k0 <= qw + 31) {
            f32x16 s0, s1;
            { const float ninit = -mrun;
#pragma unroll
              for (int i = 0; i < 16; ++i) { s0[i] = ninit; s1[i] = ninit; } }
#pragma unroll
            for (int s = 0; s < 6; ++s) {
                const s16x8 ka = *(const LAS s16x8*)(kb + r * AT_KROW + (16 * s + 8 * h) * 2);
                const s16x8 kc = *(const LAS s16x8*)(kb + (32 + r) * AT_KROW + (16 * s + 8 * h) * 2);
                s0 = MFMA32(ka, qf[s], s0); s1 = MFMA32(kc, qf[s], s1);
            }
            if (k0 + 63 > qw) {
                const int qi = qw + r - k0;
#pragma unroll
                for (int i = 0; i < 16; ++i) { const int kk = crow16(i, h); if (kk > qi) s0[i] = -1e30f; if (kk + 32 > qi) s1[i] = -1e30f; }
            }
            float mx = s0[0];
#pragma unroll
            for (int i = 1; i < 16; ++i) mx = fmaxf(mx, s0[i]);
#pragma unroll
            for (int i = 0; i < 16; ++i) mx = fmaxf(mx, s1[i]);
            mx = fmaxf(mx, __shfl_xor(mx, 32));
            if (jt == 0 || __builtin_amdgcn_ballot_w64(mx > 8.0f) != 0ull) {
                const float d = (jt == 0) ? mx : fmaxf(mx, 0.f);
                const float al = (jt == 0) ? 0.f : __builtin_amdgcn_exp2f(-d);
                mrun += d; lsum *= al;
#pragma unroll
                for (int i = 0; i < 16; ++i) { o0[i] *= al; o1[i] *= al; s0[i] -= d; s1[i] -= d; }
            }
            float ps = 0.f;
#pragma unroll
            for (int i = 0; i < 16; ++i) { s0[i] = __builtin_amdgcn_exp2f(s0[i]); s1[i] = __builtin_amdgcn_exp2f(s1[i]); ps += s0[i] + s1[i]; }
            lsum += ps;
#pragma unroll
            for (int ks = 0; ks < 4; ++ks) {
                u32x4 pw;
                if (ks == 0) { pw.x = pk2(s0[0], s0[1]); pw.y = pk2(s0[2], s0[3]); pw.z = pk2(s0[4], s0[5]); pw.w = pk2(s0[6], s0[7]); }
                else if (ks == 1) { pw.x = pk2(s0[8], s0[9]); pw.y = pk2(s0[10], s0[11]); pw.z = pk2(s0[12], s0[13]); pw.w = pk2(s0[14], s0[15]); }
                else if (ks == 2) { pw.x = pk2(s1[0], s1[1]); pw.y = pk2(s1[2], s1[3]); pw.z = pk2(s1[4], s1[5]); pw.w = pk2(s1[6], s1[7]); }
                else { pw.x = pk2(s1[8], s1[9]); pw.y = pk2(s1[10], s1[11]); pw.z = pk2(s1[12], s1[13]); pw.w = pk2(s1[14], s1[15]); }
                const s16x8 pf = __builtin_bit_cast(s16x8, pw);
                const int keyb = 32 * (ks >> 1) + 16 * (ks & 1) + 4 * h;
                u32x4 va, vb2;
                { const u32x2 lo = *(const LAS u32x2*)(vb + r * AT_VROW + keyb * 2), hi = *(const LAS u32x2*)(vb + r * AT_VROW + (keyb + 8) * 2); va.x = lo.x; va.y = lo.y; va.z = hi.x; va.w = hi.y; }
                { const u32x2 lo = *(const LAS u32x2*)(vb + (32 + r) * AT_VROW + keyb * 2), hi = *(const LAS u32x2*)(vb + (32 + r) * AT_VROW + (keyb + 8) * 2); vb2.x = lo.x; vb2.y = lo.y; vb2.z = hi.x; vb2.w = hi.y; }
                o0 = MFMA32(__builtin_bit_cast(s16x8, va), pf, o0);
                o1 = MFMA32(__builtin_bit_cast(s16x8, vb2), pf, o1);
            }
        }
        if (more) AT_STORE(lds + ((jt + 1) & 1) * AT_BUF);
    }
#undef AT_STORE
    __syncthreads();
    const float inv = 1.f / (lsum + __shfl_xor(lsum, 32));
    const int b = bh >> 3, hh = bh & 7;
    GAS bf16* orow = MIX + ((size_t)b * SEQ + qw + r) * 1024 + hh * 64 + 4 * h;
#pragma unroll
    for (int g = 0; g < 4; ++g) {
        u32x2 w0, w1;
        w0.x = pk2(o0[4 * g] * inv, o0[4 * g + 1] * inv); w0.y = pk2(o0[4 * g + 2] * inv, o0[4 * g + 3] * inv);
        w1.x = pk2(o1[4 * g] * inv, o1[4 * g + 1] * inv); w1.y = pk2(o1[4 * g + 2] * inv, o1[4 * g + 3] * inv);
        *(GAS u32x2*)(orow + 8 * g) = w0; *(GAS u32x2*)(orow + 32 + 8 * g) = w1;
    }
}
__device__ __forceinline__ void phase_attn(GAS unsigned char* ws, LAS unsigned char* lds, int tid, int lane, int wave) {
    const GAS bf16* QH = (const GAS bf16*)(ws + WS_QH); const GAS bf16* KH = (const GAS bf16*)(ws + WS_KH); const GAS bf16* VH = (const GAS bf16*)(ws + WS_VH);
    GAS bf16* MIX = (GAS bf16*)(ws + WS_MIX);
    const int c = blockIdx.x, G = gridDim.x;
    const int vcu = (G % 8 == 0) ? (c % 8) * (G / 8) + c / 8 : c;
    for (int item = vcu; item < 256; item += G) {
        const int bh = item >> 2, j = item & 3;
        for (int u = 0; u < 4; ++u) {
            const int qb = (u == 0) ? 15 - j : (u == 1) ? 8 + j : (u == 2) ? 7 - j : j;
            attn_unit(QH, KH, VH, MIX, lds, bh, qb, tid, lane, wave);
        }
    }
}

constexpr int SS_ROW = 272;
constexpr int SS_BT = 0, SS_XT = 128 * SS_ROW, SS_TAB = SS_XT + 256 * SS_ROW;
__device__ __forceinline__ void ssd_tables(const GAS float* __restrict__ DT, const GAS float* __restrict__ par, LAS float* tab, int t0, int g, int tid, float& dtv_out, float& acs_out, float& aend_out) {
    const int hl = tid >> 7, s = tid & 127, h = 4 * g + hl, ln = tid & 63;
    const float dtv = DT[(size_t)(t0 + s) * 8 + h], av = -__expf(par[P_ALOG + h]);
    float acs = dtv * av;
#pragma unroll
    for (int o = 1; o < 64; o <<= 1) { const float up = __shfl_up(acs, o); if (ln >= o) acs += up; }
    if (ln == 63) tab[tid >> 6] = acs;
    __syncthreads();
    const float lo_tot = tab[2 * hl], hi_tot = tab[2 * hl + 1];
    if (s >= 64) acs += lo_tot;
    const float aend = lo_tot + hi_tot;
    __syncthreads();
    tab[512 + tid] = acs; tab[1024 + tid] = dtv;
    dtv_out = dtv; acs_out = acs; aend_out = aend;
    __syncthreads();
}
__device__ __forceinline__ void ssd_pass_a(GAS unsigned char* ws, const GAS float* par, LAS unsigned char* lds, unsigned* uctr, int tid, int lane, int wave) {
    const GAS bf16* XC = (const GAS bf16*)(ws + WS_XBCC); const GAS float* DT = (const GAS float*)(ws + WS_DT); GAS bf16* ST = (GAS bf16*)(ws + WS_ST); GAS float* CDEC = (GAS float*)(ws + WS_CDEC);
    LAS float* tab = (LAS float*)(lds + SS_TAB);
    for (int u = blockIdx.x; u < 512; ) {
        asm volatile("" : "+v"(tid), "+v"(lane));
        const int r = lane & 31, h2 = lane >> 5;
        const int g = u & 1, c = (u >> 1) & 31, b = u >> 6, t0 = b * SEQ + c * 128;
        u32x4 bva[2], bvb[2], xva[4], xvb[4];
#pragma unroll
        for (int i = 0; i < 2; ++i) {
            const int id = tid + 512 * i, sp = id & 63, nc = id >> 6;
            const GAS bf16* src = XC + (size_t)(t0 + 2 * sp) * 1024 + 512 + g * 128 + nc * 8;
            bva[i] = *(const GAS u32x4*)src; bvb[i] = *(const GAS u32x4*)(src + 1024);
        }
#pragma unroll
        for (int i = 0; i < 4; ++i) {
            const int id = tid + 512 * i, sp = id & 63, pc = id >> 6;
            const GAS bf16* src = XC + (size_t)(t0 + 2 * sp) * 1024 + g * 256 + pc * 8;
            xva[i] = *(const GAS u32x4*)src; xvb[i] = *(const GAS u32x4*)(src + 1024);
        }
        float dtv, acs, aend;
        ssd_tables(DT, par, tab, t0, g, tid, dtv, acs, aend);
        tab[tid] = dtv * __expf(aend - acs);
        if ((tid & 127) == 127) CDEC[(size_t)(b * 32 + c) * 8 + 4 * g + (tid >> 7)] = __expf(acs);
#pragma unroll
        for (int i = 0; i < 2; ++i) {
            const int id = tid + 512 * i, sp = id & 63, nc = id >> 6;
            LAS unsigned* d = (LAS unsigned*)(lds + SS_BT + (8 * nc) * SS_ROW + sp * 4);
            TP_WRITE(d, SS_ROW / 4, bva[i], bvb[i]);
        }
        __syncthreads();
#pragma unroll
        for (int i = 0; i < 4; ++i) {
            const int id = tid + 512 * i, sp = id & 63, pc = id >> 6;
            const u32x4 va = xva[i], vb = xvb[i];
            const float sa = tab[(pc >> 3) * 128 + 2 * sp], sb2 = tab[(pc >> 3) * 128 + 2 * sp + 1];
            LAS unsigned* d = (LAS unsigned*)(lds + SS_XT + (8 * pc) * SS_ROW + sp * 4);
            d[0 * (SS_ROW / 4)] = pk2(lo16(va.x) * sa, lo16(vb.x) * sb2); d[1 * (SS_ROW / 4)] = pk2(hi16(va.x) * sa, hi16(vb.x) * sb2);
            d[2 * (SS_ROW / 4)] = pk2(lo16(va.y) * sa, lo16(vb.y) * sb2); d[3 * (SS_ROW / 4)] = pk2(hi16(va.y) * sa, hi16(vb.y) * sb2);
            d[4 * (SS_ROW / 4)] = pk2(lo16(va.z) * sa, lo16(vb.z) * sb2); d[5 * (SS_ROW / 4)] = pk2(hi16(va.z) * sa, hi16(vb.z) * sb2);
            d[6 * (SS_ROW / 4)] = pk2(lo16(va.w) * sa, lo16(vb.w) * sb2); d[7 * (SS_ROW / 4)] = pk2(hi16(va.w) * sa, hi16(vb.w) * sb2);
        }
        __syncthreads();
        f32x16 acc[4];
#pragma unroll
        for (int nb = 0; nb < 4; ++nb)
#pragma unroll
            for (int i = 0; i < 16; ++i) acc[nb][i] = 0.f;
        __builtin_amdgcn_s_setprio(1);
#pragma unroll
        for (int st = 0; st < 8; ++st) {
            const s16x8 xb = *(const LAS s16x8*)(lds + SS_XT + (32 * wave + r) * SS_ROW + (16 * st + 8 * h2) * 2);
#pragma unroll
            for (int nb = 0; nb < 4; ++nb) {
                const s16x8 ba = *(const LAS s16x8*)(lds + SS_BT + (32 * nb + r) * SS_ROW + (16 * st + 8 * h2) * 2);
                acc[nb] = MFMA32(ba, xb, acc[nb]);
            }
        }
        __builtin_amdgcn_s_setprio(0);
        GAS bf16* sp = ST + ((size_t)((b * 32 + c) * 8 + 4 * g + (wave >> 1)) * 64 + 32 * (wave & 1) + r) * 128 + 4 * h2;
#pragma unroll
        for (int nb = 0; nb < 4; ++nb)
#pragma unroll
            for (int q = 0; q < 4; ++q) { u32x2 w; w.x = pk2(acc[nb][4 * q], acc[nb][4 * q + 1]); w.y = pk2(acc[nb][4 * q + 2], acc[nb][4 * q + 3]); *(GAS u32x2*)(sp + 32 * nb + 8 * q) = w; }
        { LAS volatile int* uslot = (LAS volatile int*)(lds + 131072 + 512);
          if (tid == 0) *uslot = (int)gridDim.x + (int)__hip_atomic_fetch_add(uctr, 1u, __ATOMIC_RELAXED, __HIP_MEMORY_SCOPE_AGENT);
          __syncthreads();
          u = __builtin_amdgcn_readfirstlane(*uslot); }
    }
}
__device__ __forceinline__ void ssd_pass_b(GAS unsigned char* ws, int tid) {
    GAS bf16* ST = (GAS bf16*)(ws + WS_ST); const GAS float* CDEC = (const GAS float*)(ws + WS_CDEC);
    for (int idx = blockIdx.x * 512 + tid; idx < 64 * 2048; idx += gridDim.x * 512) {
        const int bh = idx >> 11, off = (idx & 2047) * 4, b = bh >> 3, h = bh & 7;
        GAS bf16* base = ST + (size_t)(b * 32 * 8 + h) * 8192 + off;
        u32x2 v[32]; float d[32];
#pragma unroll
        for (int c = 0; c < 32; ++c) { v[c] = *(const GAS u32x2*)(base + (size_t)c * 8 * 8192); d[c] = CDEC[(b * 32 + c) * 8 + h]; }
        float c0 = 0.f, c1 = 0.f, c2 = 0.f, c3 = 0.f;
#pragma unroll
        for (int c = 0; c < 32; ++c) {
            u32x2 o; o.x = pk2(c0, c1); o.y = pk2(c2, c3); *(GAS u32x2*)(base + (size_t)c * 8 * 8192) = o;
            c0 = d[c] * c0 + lo16(v[c].x); c1 = d[c] * c1 + hi16(v[c].x); c2 = d[c] * c2 + lo16(v[c].y); c3 = d[c] * c3 + hi16(v[c].y);
        }
    }
}
__device__ __forceinline__ void ssd_pass_c(GAS unsigned char* ws, const GAS float* par, LAS unsigned char* lds, int tid, int lane, int wave) {
    const GAS bf16* XC = (const GAS bf16*)(ws + WS_XBCC); const GAS float* DT = (const GAS float*)(ws + WS_DT); const GAS bf16* ST = (const GAS bf16*)(ws + WS_ST); const GAS bf16* Z = (const GAS bf16*)(ws + WS_Z); GAS bf16* MIX = (GAS bf16*)(ws + WS_MIX);
    LAS float* tab = (LAS float*)(lds + SS_TAB); LAS float* red = tab + 1536;
    const int lb = wave & 3, hp = wave >> 2;
    for (int u = blockIdx.x; u < 512; u += gridDim.x) {
        asm volatile("" : "+v"(tid), "+v"(lane));
        const int r = lane & 31, h2 = lane >> 5;
        const int g = u & 1, c = (u >> 1) & 31, b = u >> 6, t0 = b * SEQ + c * 128;
        const int l = 32 * lb + r;
        s16x8 cf[8];
        { const GAS bf16* crow_ = XC + (size_t)(t0 + l) * 1024 + 768 + g * 128 + 8 * h2;
#pragma unroll
          for (int st = 0; st < 8; ++st) cf[st] = *(const GAS s16x8*)(crow_ + 16 * st); }
        s16x8 pva[8], pvb[8], pvc[8], pvd[8];
        { const GAS bf16* pv = ST + ((size_t)((b * 32 + c) * 8 + 4 * g + 2 * hp) * 64 + r) * 128 + 8 * h2;
#pragma unroll
          for (int st = 0; st < 8; ++st) { pva[st] = *(const GAS s16x8*)(pv + 16 * st); pvb[st] = *(const GAS s16x8*)(pv + 32 * 128 + 16 * st);
                                           pvc[st] = *(const GAS s16x8*)(pv + 64 * 128 + 16 * st); pvd[st] = *(const GAS s16x8*)(pv + 96 * 128 + 16 * st); } }
        u32x4 bv[4], xva[4], xvb[4];
#pragma unroll
        for (int i = 0; i < 4; ++i) {
            const int id = tid + 512 * i, s = id >> 4, nc = id & 15;
            bv[i] = *(const GAS u32x4*)(XC + (size_t)(t0 + s) * 1024 + 512 + g * 128 + nc * 8);
        }
#pragma unroll
        for (int i = 0; i < 4; ++i) {
            const int id = tid + 512 * i, sp = id & 63, pc = id >> 6;
            const GAS bf16* src = XC + (size_t)(t0 + 2 * sp) * 1024 + g * 256 + pc * 8;
            xva[i] = *(const GAS u32x4*)src; xvb[i] = *(const GAS u32x4*)(src + 1024);
        }
        float dtv, acs, aend;
        ssd_tables(DT, par, tab, t0, g, tid, dtv, acs, aend);
#pragma unroll
        for (int i = 0; i < 4; ++i) { const int id = tid + 512 * i, s = id >> 4, nc = id & 15; *(LAS u32x4*)(lds + SS_BT + s * SS_ROW + nc * 16) = bv[i]; }
#pragma unroll
        for (int i = 0; i < 4; ++i) {
            const int id = tid + 512 * i, sp = id & 63, pc = id >> 6;
            LAS unsigned* d = (LAS unsigned*)(lds + SS_XT + (8 * pc) * SS_ROW + sp * 4);
            TP_WRITE(d, SS_ROW / 4, xva[i], xvb[i]);
        }
        __syncthreads();
        f32x16 ya0, ya1, yb0, yb1; float ssq = 0.f;
#pragma unroll
        for (int i = 0; i < 16; ++i) { ya0[i] = 0.f; ya1[i] = 0.f; yb0[i] = 0.f; yb1[i] = 0.f; }
        __builtin_amdgcn_s_setprio(1);
#pragma unroll
        for (int st = 0; st < 8; ++st) { ya0 = MFMA32(pva[st], cf[st], ya0); ya1 = MFMA32(pvb[st], cf[st], ya1); yb0 = MFMA32(pvc[st], cf[st], yb0); yb1 = MFMA32(pvd[st], cf[st], yb1); }
        __builtin_amdgcn_s_setprio(0);
        { const float ea = __expf(tab[512 + (2 * hp) * 128 + l]), eb = __expf(tab[512 + (2 * hp + 1) * 128 + l]);
#pragma unroll
          for (int i = 0; i < 16; ++i) { ya0[i] *= ea; ya1[i] *= ea; yb0[i] *= eb; yb1[i] *= eb; } }
        u32x2 xq[2][8], zq[2][8];
#define SS_LOAD_XZ(hd) do { const int hh_ = 4 * g + 2 * hp + (hd); \
            const GAS bf16* xrow = XC + (size_t)(t0 + l) * 1024 + hh_ * 64 + 4 * h2; const GAS bf16* zrow = Z + (size_t)(t0 + l) * 512 + hh_ * 64 + 4 * h2; \
            _Pragma("unroll") for (int q = 0; q < 4; ++q) { xq[hd][2 * q] = *(const GAS u32x2*)(xrow + 8 * q); xq[hd][2 * q + 1] = *(const GAS u32x2*)(xrow + 32 + 8 * q); \
                                          zq[hd][2 * q] = *(const GAS u32x2*)(zrow + 8 * q); zq[hd][2 * q + 1] = *(const GAS u32x2*)(zrow + 32 + 8 * q); } } while (0)
        SS_LOAD_XZ(0);
        f32x16 gt[4];
        __builtin_amdgcn_s_setprio(1);
#pragma unroll
        for (int sb = 0; sb < 4; ++sb) {
#pragma unroll
            for (int i = 0; i < 16; ++i) gt[sb][i] = 0.f;
            if (sb <= lb) {
#pragma unroll
                for (int st = 0; st < 8; ++st) {
                    const s16x8 ba = *(const LAS s16x8*)(lds + SS_BT + (32 * sb + r) * SS_ROW + (16 * st + 8 * h2) * 2);
                    gt[sb] = MFMA32(ba, cf[st], gt[sb]);
                }
            }
        }
        __builtin_amdgcn_s_setprio(0);
#pragma unroll
        for (int hd = 0; hd < 2; ++hd) {
            const int hl = 2 * hp + hd, hh = 4 * g + hl;
            const float acs_l = tab[512 + hl * 128 + l];
            f32x16& y0 = hd == 0 ? ya0 : yb0; f32x16& y1 = hd == 0 ? ya1 : yb1;
#pragma unroll
            for (int sb = 0; sb < 4; ++sb) {
                if (sb <= lb) {
                    float w[16];
                    int lim = (sb == lb) ? r : 64;
                    asm volatile("" : "+v"(lim));
#pragma unroll
                    for (int i = 0; i < 16; ++i) {
                        const int s = 32 * sb + crow16(i, h2);
                        const float as = tab[512 + hl * 128 + s], ds = tab[1024 + hl * 128 + s];
                        const float keep = (crow16(i, h2) <= lim) ? ds : 0.f;
                        w[i] = gt[sb][i] * __expf(fminf(acs_l - as, 0.f)) * keep;
                    }
#pragma unroll
                    for (int ks = 0; ks < 2; ++ks) {
                        u32x4 pw; pw.x = pk2(w[8 * ks], w[8 * ks + 1]); pw.y = pk2(w[8 * ks + 2], w[8 * ks + 3]); pw.z = pk2(w[8 * ks + 4], w[8 * ks + 5]); pw.w = pk2(w[8 * ks + 6], w[8 * ks + 7]);
                        const s16x8 pf = __builtin_bit_cast(s16x8, pw);
                        const int keyb = 32 * sb + 16 * ks + 4 * h2;
                        u32x4 va, vb;
                        { LAS unsigned char* xr = lds + SS_XT + (hl * 64 + r) * SS_ROW; const u32x2 lo = *(const LAS u32x2*)(xr + keyb * 2), hi = *(const LAS u32x2*)(xr + (keyb + 8) * 2); va.x = lo.x; va.y = lo.y; va.z = hi.x; va.w = hi.y; }
                        { LAS unsigned char* xr = lds + SS_XT + (hl * 64 + 32 + r) * SS_ROW; const u32x2 lo = *(const LAS u32x2*)(xr + keyb * 2), hi = *(const LAS u32x2*)(xr + (keyb + 8) * 2); vb.x = lo.x; vb.y = lo.y; vb.z = hi.x; vb.w = hi.y; }
                        y0 = MFMA32(__builtin_bit_cast(s16x8, va), pf, y0);
                        y1 = MFMA32(__builtin_bit_cast(s16x8, vb), pf, y1);
                    }
                }
            }
            if (hd == 0) SS_LOAD_XZ(1);
            const float dsk = par[P_DSKIP + hh];
#pragma unroll
            for (int q = 0; q < 4; ++q) {
                const u32x2 x0 = xq[hd][2 * q], x1 = xq[hd][2 * q + 1], z0 = zq[hd][2 * q], z1 = zq[hd][2 * q + 1];
                y0[4 * q] = (y0[4 * q] + dsk * lo16(x0.x)) * silu_f(lo16(z0.x)); y0[4 * q + 1] = (y0[4 * q + 1] + dsk * hi16(x0.x)) * silu_f(hi16(z0.x));
                y0[4 * q + 2] = (y0[4 * q + 2] + dsk * lo16(x0.y)) * silu_f(lo16(z0.y)); y0[4 * q + 3] = (y0[4 * q + 3] + dsk * hi16(x0.y)) * silu_f(hi16(z0.y));
                y1[4 * q] = (y1[4 * q] + dsk * lo16(x1.x)) * silu_f(lo16(z1.x)); y1[4 * q + 1] = (y1[4 * q + 1] + dsk * hi16(x1.x)) * silu_f(hi16(z1.x));
                y1[4 * q + 2] = (y1[4 * q + 2] + dsk * lo16(x1.y)) * silu_f(lo16(z1.y)); y1[4 * q + 3] = (y1[4 * q + 3] + dsk * hi16(x1.y)) * silu_f(hi16(z1.y));
            }
#pragma unroll
            for (int i = 0; i < 16; ++i) { ssq += y0[i] * y0[i] + y1[i] * y1[i]; }
        }
#undef SS_LOAD_XZ
        ssq += __shfl_xor(ssq, 32);
        if (h2 == 0) red[hp * 128 + l] = ssq;
        __syncthreads();
        {
            const float rn = rsqrtf((red[l] + red[128 + l]) * (1.f / 256.f) + EPS);
#pragma unroll
            for (int hd = 0; hd < 2; ++hd) {
                const int hl = 2 * hp + hd;
                const GAS float* nw = par + P_SSDNW + g * 256 + hl * 64 + 4 * h2;
                GAS bf16* mrow = MIX + (size_t)(t0 + l) * 1024 + 512 + g * 256 + hl * 64 + 4 * h2;
#pragma unroll
                for (int q = 0; q < 4; ++q) {
                    const f32x4 w0 = *(const GAS f32x4*)(nw + 8 * q), w1 = *(const GAS f32x4*)(nw + 32 + 8 * q);
                    const f32x16& u0 = hd == 0 ? ya0 : yb0; const f32x16& u1 = hd == 0 ? ya1 : yb1;
                    u32x2 o0, o1;
                    o0.x = pk2(u0[4 * q] * rn * w0[0], u0[4 * q + 1] * rn * w0[1]); o0.y = pk2(u0[4 * q + 2] * rn * w0[2], u0[4 * q + 3] * rn * w0[3]);
                    o1.x = pk2(u1[4 * q] * rn * w1[0], u1[4 * q + 1] * rn * w1[1]); o1.y = pk2(u1[4 * q + 2] * rn * w1[2], u1[4 * q + 3] * rn * w1[3]);
                    *(GAS u32x2*)(mrow + 8 * q) = o0; *(GAS u32x2*)(mrow + 32 + 8 * q) = o1;
                }
            }
        }
        __syncthreads();
    }
}

#define XB_TMO      128
#define XB_XCNT(j)  (256  + 64 * (j))
#define XB_XSUB(j)  (1280 + 64 * (j))
#define XB_XGEN(j)  (2304 + 64 * (j))
#define XB_TOP      3328
#define XB_TOPGEN   3392
#define XCD_BAR_WORDS 3456
#define XB_SPIN_CAP (1u << 18)

__device__ __forceinline__ unsigned xb_ld(unsigned* p)              { return __hip_atomic_load(p, __ATOMIC_RELAXED, __HIP_MEMORY_SCOPE_AGENT); }
__device__ __forceinline__ unsigned xb_add(unsigned* p, unsigned v) { return __hip_atomic_fetch_add(p, v, __ATOMIC_RELAXED, __HIP_MEMORY_SCOPE_AGENT); }
__device__ __forceinline__ unsigned xb_xcc_id() { return (unsigned)__builtin_amdgcn_s_getreg((3 << 11) | 20) & 0xFu; }
#define XB_SPIN(cond, bar) do { unsigned _sp = 0; while (cond) { __builtin_amdgcn_s_sleep(1); \
    if ((++_sp & 255u) == 0u) { if (xb_ld(&(bar)[XB_TMO])) break; if (_sp > XB_SPIN_CAP) { atomicAdd(&(bar)[XB_TMO], 1u); break; } } } } while (0)

struct XcdBarrier {
    unsigned* bar; unsigned x;
    volatile LAS unsigned* st;
};

__device__ __forceinline__ XcdBarrier xcd_barrier_post(unsigned* bar, volatile LAS unsigned* st) {
    XcdBarrier b; b.bar = bar; b.x = xb_xcc_id(); b.st = st;
    if (threadIdx.x == 0) (void)xb_add(&bar[XB_XCNT(b.x)], 1u);
    return b;
}
__device__ __forceinline__ void xcd_barrier_complete(unsigned* bar, unsigned x, unsigned& nloc, unsigned& nx) {
    const unsigned G = gridDim.x * gridDim.y * gridDim.z;
    unsigned sum, cnt, mine, sp = 0u;
    for (;;) {
        sum = 0u; cnt = 0u; mine = 0u;
#pragma unroll
        for (unsigned j = 0; j < 16; ++j) { const unsigned c = xb_ld(&bar[XB_XCNT(j)]); sum += c; cnt += (c > 0u) ? 1u : 0u; mine = (j == x) ? c : mine; }
        if (sum == G) break;
        __builtin_amdgcn_s_sleep(1);
        if ((++sp & 255u) == 0u) { if (xb_ld(&bar[XB_TMO])) break; if (sp > XB_SPIN_CAP) { atomicAdd(&bar[XB_TMO], 1u); break; } }
    }
    nloc = mine > 0u ? mine : 1u; nx = cnt > 0u ? cnt : 1u;
}

__device__ __forceinline__ void xcd_barrier(const XcdBarrier& b) {
    asm volatile("s_waitcnt vmcnt(0)" ::: "memory");
    __syncthreads();
    if (threadIdx.x == 0) {
        unsigned* bar = b.bar; asm volatile("" : "+s"(bar));
        __builtin_amdgcn_s_waitcnt(0);
        unsigned nloc = b.st[0], nx = b.st[1];
        if (nloc == 0u) { xcd_barrier_complete(bar, b.x, nloc, nx); b.st[0] = nloc; b.st[1] = nx; }
        const unsigned old = xb_add(&bar[XB_XSUB(b.x)], 1u);
        const unsigned gen = old / nloc;
        if (old + 1u == (gen + 1u) * nloc) {
            __builtin_amdgcn_fence(__ATOMIC_RELEASE, "agent");
            asm volatile("s_waitcnt vmcnt(0)" ::: "memory");
            const unsigned og = xb_add(&bar[XB_TOP], 1u);
            const unsigned tg = og / nx;
            if (og + 1u == (tg + 1u) * nx) xb_add(&bar[XB_TOPGEN], 1u);
            else XB_SPIN(xb_ld(&bar[XB_TOPGEN]) == tg, bar);
            __builtin_amdgcn_fence(__ATOMIC_ACQUIRE, "agent");
            xb_add(&bar[XB_XGEN(b.x)], 1u);
            asm volatile("s_waitcnt vmcnt(0)" ::: "memory");
        } else {
            XB_SPIN(xb_ld(&bar[XB_XGEN(b.x)]) == gen, bar);
            __builtin_amdgcn_fence(__ATOMIC_ACQUIRE, "agent");
            asm volatile("s_waitcnt vmcnt(0)" ::: "memory");
        }
    }
    __syncthreads();
}


#define GSYNC() xcd_barrier(xbar)
#define PH_PTRS GAS unsigned char* ws = ws0; asm volatile("" : "+s"(ws)); const GAS float* modl = (const GAS float*)(ws + WS_MOD) + (size_t)l * 8 * 6144; const GAS unsigned char* wl = ws + WS_W + (size_t)l * WL_STRIDE; \
    const GAS float* par = (const GAS float*)(ws + WS_PAR) + (size_t)l * P_STRIDE; (void)modl; (void)wl; (void)par;
#define PH_IDS int tid = threadIdx.x; asm volatile("" : "+v"(tid)); const int lane = tid & 63, wave = __builtin_amdgcn_readfirstlane(tid >> 6); (void)lane; (void)wave;
__device__ __forceinline__ void layer_body(const Args& a, GAS unsigned char* ws0, LAS unsigned char* lds, const XcdBarrier& xbar, const int l) {
        const GAS float* xf32 = as_global(a.in[I_X]);
        GAS float* const outp = as_global(a.out);
        if (l == 0) { PH_PTRS PH_IDS phase_norm<false>(xf32, par + P_N1W, modl, 0, 1024, (GAS bf16*)(ws + WS_H), lane, wave); }
        else        { PH_PTRS PH_IDS phase_norm<true>(outp, par + P_N1W, modl, 0, 1024, (GAS bf16*)(ws + WS_H), lane, wave); }
        GSYNC();
        { PH_PTRS EpiIn E{(GAS bf16*)(ws + WS_QA), (GAS bf16*)(ws + WS_Z), (GAS bf16*)(ws + WS_XBC), (GAS float*)(ws + WS_MISC)};
          run_gemm(lds, (const GAS bf16*)(ws + WS_H), (const GAS bf16*)(wl + WO_IN), DINP, D, E); }
        GSYNC();
        { PH_PTRS PH_IDS phase_c(ws, par, tid, lane, wave); }
        GSYNC();
        { PH_PTRS EpiQkv E{(const GAS float*)(ws + WS_RINV), (const GAS float*)(ws + WS_COS), (const GAS float*)(ws + WS_SIN), par, (GAS bf16*)(ws + WS_QH), (GAS bf16*)(ws + WS_KH), (GAS bf16*)(ws + WS_VH)};
          pg8::Gemm gq{(const bf16*)(ws + WS_QA), (const bf16*)(wl + WO_Q), T, NQ + NKV, 512}; QkvOrder S; S.S.init(T, NQ + NKV, (int)gridDim.x, (int)blockIdx.x);
          pg8::gemm_phase<EpiQkv, QkvOrder, true, true>(lds, gq, S, E); }
        __syncthreads();
        { PH_PTRS PH_IDS ssd_pass_a(ws, par, lds, (unsigned*)(ws + WS_CTL + 16384) + 64 * l, tid, lane, wave); }
        GSYNC();
        { PH_PTRS PH_IDS phase_attn(ws, lds, tid, lane, wave); }
        { PH_PTRS PH_IDS ssd_pass_b(ws, tid); }
        GSYNC();
        { PH_PTRS PH_IDS ssd_pass_c(ws, par, lds, tid, lane, wave); }
        GSYNC();
        if (l == 0) { PH_PTRS EpiResT<false, true> E{xf32, ws + WS_X1, modl + 2048}; run_gemm(lds, (const GAS bf16*)(ws + WS_MIX), (const GAS bf16*)(wl + WO_OUT), D, D, E); }
        else        { PH_PTRS EpiResT<true, true> E{outp, ws + WS_X1, modl + 2048}; run_gemm(lds, (const GAS bf16*)(ws + WS_MIX), (const GAS bf16*)(wl + WO_OUT), D, D, E); }
        GSYNC();
        { PH_PTRS PH_IDS phase_norm<true>(ws + WS_X1, par + P_N2W, modl, 3072, 4096, (GAS bf16*)(ws + WS_H), lane, wave); }
        GSYNC();
        { PH_PTRS EpiSwiglu E{(GAS bf16*)(ws + WS_ACT)}; run_gemm(lds, (const GAS bf16*)(ws + WS_H), (const GAS bf16*)(wl + WO_GU), NGU, D, E); }
        GSYNC();
        if (l + 1 < DEPTH) { PH_PTRS EpiResT<true, true> E2{ws + WS_X1, outp, modl + 5120}; run_gemm(lds, (const GAS bf16*)(ws + WS_ACT), (const GAS bf16*)(wl + WO_D), D, DFF, E2); }
        else               { PH_PTRS EpiResT<true, false> E2{ws + WS_X1, outp, modl + 5120}; run_gemm(lds, (const GAS bf16*)(ws + WS_ACT), (const GAS bf16*)(wl + WO_D), D, DFF, E2); }
        if (l + 1 < DEPTH) GSYNC();
}

__global__ void __launch_bounds__(NWAVES * 64, 2) mega_fwd(Args a) {
    extern __shared__ __attribute__((aligned(16))) unsigned char lds_raw[];
    LAS unsigned char* lds = (LAS unsigned char*)lds_raw;
    cg::grid_group grid = cg::this_grid();
    GAS unsigned char* const ws0 = as_global(a.ws);
    GAS unsigned char* ws = ws0;
    volatile LAS unsigned* xst = (volatile LAS unsigned*)(lds + 131072 + 64);
    if (threadIdx.x < 4) xst[threadIdx.x] = 0u;
    __syncthreads();
    const XcdBarrier xbar = xcd_barrier_post((unsigned*)(ws + WS_CTL), xst);
    { PH_IDS
    phase_prep(a, lds, tid, lane, wave); }
    __syncthreads();
    { PH_IDS phase_prep_mod(a, lds, tid, lane, wave); }
    if (a.ph_hi == 0x7fffffff) grid.sync();
    xcd_barrier(xbar);
    layer_body(a, ws0, lds, xbar, 0);
    layer_body(a, ws0, lds, xbar, 1);
}

extern "C" void kernel_launch(void* const* d_in, const int* in_sizes, int n_in, void* d_out, int out_size, void* d_ws, size_t ws_size, hipStream_t stream) {
    static int grid_blocks = 0;
    if (!grid_blocks) {
        int dev = 0, cus = 0, per_cu = 0;
        hipGetDevice(&dev);
        hipDeviceGetAttribute(&cus, hipDeviceAttributeMultiprocessorCount, dev);
        if (hipFuncSetAttribute((const void*)mega_fwd, hipFuncAttributeMaxDynamicSharedMemorySize, LDS_BYTES) != hipSuccess) fprintf(stderr, "hipFuncSetAttribute failed\n");
        hipOccupancyMaxActiveBlocksPerMultiprocessor(&per_cu, (const void*)mega_fwd, NWAVES * 64, LDS_BYTES);
        if (per_cu < 1) per_cu = 1;
        grid_blocks = cus;
        if (ws_size < WS_END) fprintf(stderr, "kernel_launch: d_ws too small: %zu < %zu\n", ws_size, (size_t)WS_END);
    }
    Args a{};
    for (int i = 0; i < 25; ++i) a.in[i] = (const float*)d_in[i];
    a.out = (float*)d_out; a.ws = (unsigned char*)d_ws; a.ph_lo = 0; a.ph_hi = 0;
    hipMemsetAsync((unsigned char*)d_ws + WS_CTL, 0, 16384 + 1024, stream);
    void* args[] = {&a};
    hipError_t e = hipLaunchCooperativeKernel((const void*)mega_fwd, dim3(grid_blocks), dim3(NWAVES * 64), args, LDS_BYTES, stream);
    if (e != hipSuccess) fprintf(stderr, "cooperative launch failed: %s (grid %d)\n", hipGetErrorString(e), grid_blocks);
}
```
